# Optimizing an MI355X kernel written in HIP

```python
import math
import jax, jax.numpy as jnp
from jax import lax
import numpy as np

D_MODEL = 1024
BATCH = 4
SEQ = 8192
DEPTH = 4

HEAD_DIM = 64
ROPE_THETA = 10000.0
EPS = 1e-6
NEG_INF = -1e30
Q_BLOCK = 128
MLA_HEADS = 4
MLA_Q_RANK = 256
MLA_KV_RANK = 128
MLA_NOPE = 64
MLA_ROPE = 32
MLA_V = 64
SWA_HEADS = 4
SWA_KV_HEADS = 2
SWA_WINDOW = 128
DIFF_HEADS = 4
DIFF_QK = 32
DIFF_V = 2 * DIFF_QK
HY_CH = 256
HY_ORDER = 2
HY_DIRS = 2
HY_SHORT = 3
HY_EMB = 33
HY_BANDS = (HY_EMB - 1) // 2
HY_FFN = 64
HY_TARGET = 1e-2
HY_MIN_DECAY = math.log(HY_TARGET) / 1.5
HY_MAX_DECAY = math.log(HY_TARGET) / 0.3
MLA_COLS = MLA_Q_RANK + MLA_KV_RANK + MLA_ROPE
SWA_COLS = (SWA_HEADS + 2 * SWA_KV_HEADS) * HEAD_DIM
DIFF_COLS = DIFF_HEADS * (4 * DIFF_QK + DIFF_V)
HY_COLS = (HY_ORDER + 1) * HY_CH
IN_COLS = MLA_COLS + SWA_COLS + DIFF_COLS + HY_COLS
D_MIX = MLA_HEADS * MLA_V + SWA_HEADS * HEAD_DIM + DIFF_HEADS * DIFF_V + HY_CH
N_GROUPS = 4
EXPERTS_PER_GROUP = 8
N_EXPERTS = N_GROUPS * EXPERTS_PER_GROUP
TOP_K = 2
D_EXPERT = 256
MOE_BLOCK = 128

kernel_name = 'hybrid_parallel_heads_hier_moe_encoder'


def rms_norm(x, g):
    x32 = x.astype(jnp.float32)
    y = x32 * lax.rsqrt(jnp.mean(x32 * x32, axis=-1, keepdims=True) + EPS)
    return (y * g.astype(jnp.float32)).astype(x.dtype)


def rope(x, positions):
    half = x.shape[-1] // 2
    inv_freq = jnp.exp(-math.log(ROPE_THETA) * jnp.arange(half, dtype=jnp.float32) / half)
    ang = positions.astype(jnp.float32)[:, None, :, None] * inv_freq
    cos, sin = jnp.cos(ang), jnp.sin(ang)
    x32 = x.astype(jnp.float32)
    x1, x2 = x32[..., :half], x32[..., half:]
    return jnp.concatenate([x1 * cos - x2 * sin, x1 * sin + x2 * cos], axis=-1).astype(x.dtype)


def to_heads(t, n_heads):
    B, S, _ = t.shape
    return t.reshape(B, S, n_heads, -1).transpose(0, 2, 1, 3)


def from_heads(t):
    B, H, S, d = t.shape
    return t.transpose(0, 2, 1, 3).reshape(B, S, H * d)


def query_blocks(q):
    B, H, S, d = q.shape
    return jnp.moveaxis(q.reshape(B, H, S // Q_BLOCK, Q_BLOCK, d), 2, 0)


def merge_query_blocks(o):
    nb, B, H, qb, d = o.shape
    return jnp.moveaxis(o, 0, 2).reshape(B, H, nb * qb, d)


def dense_attention(q, k, v, scale):
    def attend(qi):
        s = jnp.einsum('bhqd,bhkd->bhqk', qi, k).astype(jnp.float32) * scale
        p = jax.nn.softmax(s, axis=-1)
        return jnp.einsum('bhqk,bhkd->bhqd', p.astype(v.dtype), v)
    return merge_query_blocks(lax.map(attend, query_blocks(q)))


def mla_mixer(cols, positions, q_norm, kv_norm, w_uq, w_ukv):
    c_q, c_kv, k_pe = jnp.split(cols, [MLA_Q_RANK, MLA_Q_RANK + MLA_KV_RANK], axis=-1)
    q = to_heads(rms_norm(c_q, q_norm) @ w_uq, MLA_HEADS)
    kv = to_heads(rms_norm(c_kv, kv_norm) @ w_ukv, MLA_HEADS)
    q_nope, q_pe = q[..., :MLA_NOPE], q[..., MLA_NOPE:]
    k_nope, v = kv[..., :MLA_NOPE], kv[..., MLA_NOPE:]
    k_pe = rope(k_pe[:, None], positions)
    q = jnp.concatenate([q_nope, rope(q_pe, positions)], axis=-1)
    k = jnp.concatenate([k_nope, jnp.broadcast_to(k_pe, k_nope.shape[:-1] + (MLA_ROPE,))], axis=-1)
    o = dense_attention(q, k, v, (MLA_NOPE + MLA_ROPE) ** -0.5)
    return from_heads(o)


def band_blocks(t):
    B, H, S, d = t.shape
    nb = S // SWA_WINDOW
    tp = jnp.pad(t, ((0, 0), (0, 0), (SWA_WINDOW, SWA_WINDOW), (0, 0)))
    tp = tp.reshape(B, H, nb + 2, SWA_WINDOW, d)
    return jnp.concatenate([tp[:, :, :-2], tp[:, :, 1:-1], tp[:, :, 2:]], axis=3)


def swa_mixer(cols, positions, sink):
    B, S, _ = cols.shape
    W = SWA_WINDOW
    nb = S // W
    G = SWA_HEADS // SWA_KV_HEADS
    q, k, v = jnp.split(cols, [SWA_HEADS * HEAD_DIM, (SWA_HEADS + SWA_KV_HEADS) * HEAD_DIM], axis=-1)
    q = rope(to_heads(q, SWA_HEADS), positions).reshape(B, SWA_KV_HEADS, G, nb, W, HEAD_DIM)
    kb = band_blocks(rope(to_heads(k, SWA_KV_HEADS), positions))
    vb = band_blocks(to_heads(v, SWA_KV_HEADS))
    s = jnp.einsum('bhgnqd,bhnkd->bhgnqk', q, kb).astype(jnp.float32) * HEAD_DIM ** -0.5
    qi = jnp.arange(W)[:, None]
    kj = jnp.arange(3 * W)[None, :]
    band = jnp.abs(kj - W - qi) <= W
    kpos = (jnp.arange(nb)[:, None] - 1) * W + jnp.arange(3 * W)[None, :]
    valid = band[None] & ((kpos >= 0) & (kpos < S))[:, None, :]
    s = jnp.where(valid, s, NEG_INF)
    sink32 = sink.astype(jnp.float32).reshape(1, SWA_KV_HEADS, G, 1, 1, 1)
    m = jnp.maximum(jnp.max(s, axis=-1, keepdims=True), sink32)
    e = jnp.exp(s - m)
    p = e / (jnp.sum(e, axis=-1, keepdims=True) + jnp.exp(sink32 - m))
    o = jnp.einsum('bhgnqk,bhnkd->bhgnqd', p.astype(vb.dtype), vb)
    return from_heads(o.reshape(B, SWA_HEADS, S, HEAD_DIM))


def diff_mixer(cols, positions, lam_vecs, norm_g, lambda_init):
    B, S, _ = cols.shape
    q, k, v = jnp.split(cols, [DIFF_HEADS * 2 * DIFF_QK, DIFF_HEADS * 4 * DIFF_QK], axis=-1)
    q = q.reshape(B, S, DIFF_HEADS, 2, DIFF_QK)
    k = k.reshape(B, S, DIFF_HEADS, 2, DIFF_QK)
    q1 = rope(q[..., 0, :].transpose(0, 2, 1, 3), positions)
    q2 = rope(q[..., 1, :].transpose(0, 2, 1, 3), positions)
    k1 = rope(k[..., 0, :].transpose(0, 2, 1, 3), positions)
    k2 = rope(k[..., 1, :].transpose(0, 2, 1, 3), positions)
    v = to_heads(v, DIFF_HEADS)
    lv = lam_vecs.astype(jnp.float32)
    lam = jnp.exp(jnp.sum(lv[0] * lv[1])) - jnp.exp(jnp.sum(lv[2] * lv[3])) + lambda_init
    scale = DIFF_QK ** -0.5

    def attend(qs):
        q1i, q2i = qs
        p1 = jax.nn.softmax(jnp.einsum('bhqd,bhkd->bhqk', q1i, k1).astype(jnp.float32) * scale, axis=-1)
        p2 = jax.nn.softmax(jnp.einsum('bhqd,bhkd->bhqk', q2i, k2).astype(jnp.float32) * scale, axis=-1)
        return jnp.einsum('bhqk,bhkd->bhqd', (p1 - lam * p2).astype(v.dtype), v)

    o = merge_query_blocks(lax.map(attend, (query_blocks(q1), query_blocks(q2))))
    o = rms_norm(o, norm_g) * (1.0 - lambda_init)
    return from_heads(o)


def hyena_filters(L, w1, b1, w2, b2, w3, b3, w4, sin_freq):
    t = jnp.linspace(0.0, 1.0, L, dtype=jnp.float32)
    w = 2.0 * math.pi * jnp.arange(L, dtype=jnp.float32) / L
    f = jnp.linspace(1e-4, HY_BANDS - 1, HY_BANDS, dtype=jnp.float32)
    z = jnp.concatenate([t[:, None], jnp.cos(w[:, None] * f), -jnp.sin(w[:, None] * f)], axis=-1)
    z = z.astype(w1.dtype)
    h = jnp.sin(sin_freq[0] * (z @ w1 + b1))
    h = jnp.sin(sin_freq[1] * (h @ w2 + b2))
    h = jnp.sin(sin_freq[2] * (h @ w3 + b3))
    h = (h @ w4).astype(jnp.float32).reshape(L, HY_DIRS, HY_ORDER, HY_CH)
    decay = jnp.linspace(HY_MIN_DECAY, HY_MAX_DECAY, HY_CH, dtype=jnp.float32)
    window = jnp.exp(-t[:, None] * jnp.abs(decay))
    return h * window[:, None, None, :]


def two_sided_filter(h_fwd, h_bwd):
    C = h_fwd.shape[-1]
    filt = jnp.concatenate([h_fwd[:1] + h_bwd[:1], h_fwd[1:], jnp.zeros((1, C), h_fwd.dtype), h_bwd[:0:-1]], axis=0)
    return filt * lax.rsqrt(jnp.sum(filt * filt, axis=0, keepdims=True) + EPS)


def fft_long_conv(u, filt, bias):
    L = u.shape[1]
    u32 = u.astype(jnp.float32)
    U = jnp.fft.rfft(u32, n=2 * L, axis=1)
    F = jnp.fft.rfft(filt, axis=0)
    y = jnp.fft.irfft(U * F[None], n=2 * L, axis=1)[:, :L]
    return (y + u32 * bias.astype(jnp.float32)).astype(u.dtype)


def hyena_mixer(cols, conv_w, conv_b, w1, b1, w2, b2, w3, b3, w4, sin_freq, bias):
    B, S, C_in = cols.shape
    u = lax.conv_general_dilated(cols, conv_w[:, None, :], (1,), [(HY_SHORT // 2, HY_SHORT // 2)],
                                 dimension_numbers=('NWC', 'WIO', 'NWC'),
                                 feature_group_count=C_in) + conv_b
    v, x1, x2 = jnp.split(u, HY_ORDER + 1, axis=-1)
    filters = hyena_filters(S, w1, b1, w2, b2, w3, b3, w4, sin_freq)
    z = v
    for o, gate in enumerate((x1, x2)):
        z = gate * fft_long_conv(z, two_sided_filter(filters[:, 0, o], filters[:, 1, o]), bias[o])
    return z


def grouped_expert_ffn(ht, expert_idx, gate, w_gate, w_up, w_down):
    T, D = ht.shape
    E = w_gate.shape[0]
    A = T * TOP_K
    flat_e = expert_idx.reshape(A)
    flat_tok = jnp.repeat(jnp.arange(T, dtype=jnp.int32), TOP_K)
    flat_g = gate.reshape(A)
    order = jnp.argsort(flat_e)
    se = flat_e[order]
    counts = jnp.bincount(flat_e, length=E)
    padded = (counts + MOE_BLOCK - 1) // MOE_BLOCK * MOE_BLOCK
    pad_end = jnp.cumsum(padded)
    pad_start = pad_end - padded
    start = jnp.cumsum(counts) - counts
    dest = pad_start[se] + (jnp.arange(A, dtype=jnp.int32) - start[se])
    n_blocks = (A + E * (MOE_BLOCK - 1) + MOE_BLOCK - 1) // MOE_BLOCK
    P = n_blocks * MOE_BLOCK
    slot_tok = jnp.full((P,), T, jnp.int32).at[dest].set(flat_tok[order])
    slot_gate = jnp.zeros((P,), flat_g.dtype).at[dest].set(flat_g[order])
    block_expert = jnp.minimum(
        jnp.searchsorted(pad_end, jnp.arange(n_blocks, dtype=jnp.int32) * MOE_BLOCK, side='right'), E - 1)
    h_pad = jnp.concatenate([ht, jnp.zeros((1, D), ht.dtype)], axis=0)
    xb = h_pad[slot_tok].reshape(n_blocks, MOE_BLOCK, D)

    def expert_block(args):
        xe, e = args
        return (jax.nn.silu(xe @ w_gate[e]) * (xe @ w_up[e])) @ w_down[e]

    yb = lax.map(expert_block, (xb, block_expert)).reshape(P, D)
    y = jnp.zeros((T + 1, D), ht.dtype).at[slot_tok].add(yb * slot_gate[:, None].astype(yb.dtype))
    return y[:T]


def hier_moe(h, rg_w, rg_b, re_w, re_b, w_gate, w_up, w_down):
    B, S, D = h.shape
    T = B * S
    ht = h.reshape(T, D)
    pg = jax.nn.softmax((ht @ rg_w + rg_b).astype(jnp.float32), axis=-1)
    pg_top, g_sel = lax.top_k(pg, 1)
    le = (ht @ re_w + re_b).astype(jnp.float32).reshape(T, N_GROUPS, EXPERTS_PER_GROUP)
    idx = jnp.broadcast_to(g_sel[:, :, None], (T, 1, EXPERTS_PER_GROUP))
    le_sel = jnp.take_along_axis(le, idx, axis=1)[:, 0]
    top_v, top_i = lax.top_k(le_sel, TOP_K)
    expert_idx = g_sel * EXPERTS_PER_GROUP + top_i
    gate = pg_top * jax.nn.softmax(top_v, axis=-1)
    return grouped_expert_ffn(ht, expert_idx, gate, w_gate, w_up, w_down).reshape(B, S, D)


def setup_inputs(seed: int = 0) -> dict:
    key = jax.random.key(seed)
    ks = iter(jax.random.split(key, 48))

    def nrm(shape, scale):
        return scale * jax.random.normal(next(ks), shape, jnp.float32)

    L, D = DEPTH, D_MODEL
    return {
        'x': nrm((BATCH, SEQ, D), 1.0),
        'c': nrm((BATCH, D), 1.0),
        'positions': jnp.broadcast_to(jnp.arange(SEQ, dtype=jnp.int32), (BATCH, SEQ)),
        'ln1_g': 1.0 + nrm((L, D), 0.02),
        'ln2_g': 1.0 + nrm((L, D), 0.02),
        'ada_w': nrm((L, D, 6 * D), 0.5 * D ** -0.5),
        'ada_b': nrm((L, 6 * D), 0.02),
        'w_in': nrm((L, D, IN_COLS), D ** -0.5),
        'mla_q_norm': 1.0 + nrm((L, MLA_Q_RANK), 0.02),
        'mla_kv_norm': 1.0 + nrm((L, MLA_KV_RANK), 0.02),
        'mla_w_uq': nrm((L, MLA_Q_RANK, MLA_HEADS * (MLA_NOPE + MLA_ROPE)), MLA_Q_RANK ** -0.5),
        'mla_w_ukv': nrm((L, MLA_KV_RANK, MLA_HEADS * (MLA_NOPE + MLA_V)), MLA_KV_RANK ** -0.5),
        'swa_sink': nrm((L, SWA_HEADS), 0.5),
        'diff_lambda': nrm((L, 4, DIFF_QK), 0.1),
        'diff_norm_g': 1.0 + nrm((L, DIFF_V), 0.02),
        'hy_conv_w': nrm((L, HY_SHORT, HY_COLS), HY_SHORT ** -0.5),
        'hy_conv_b': nrm((L, HY_COLS), 0.02),
        'hy_w1': nrm((L, HY_EMB, HY_FFN), HY_EMB ** -0.5),
        'hy_b1': nrm((L, HY_FFN), 0.02),
        'hy_w2': nrm((L, HY_FFN, HY_FFN), HY_FFN ** -0.5),
        'hy_b2': nrm((L, HY_FFN), 0.02),
        'hy_w3': nrm((L, HY_FFN, HY_FFN), HY_FFN ** -0.5),
        'hy_b3': nrm((L, HY_FFN), 0.02),
        'hy_w4': nrm((L, HY_FFN, HY_DIRS * HY_ORDER * HY_CH), HY_FFN ** -0.5),
        'hy_sin_freq': 1.0 + nrm((L, 3, HY_FFN), 0.02),
        'hy_bias': nrm((L, HY_ORDER, HY_CH), 0.1),
        'w_out': nrm((L, D_MIX, D), D_MIX ** -0.5),
        'router_g_w': nrm((L, D, N_GROUPS), D ** -0.5),
        'router_g_b': nrm((L, N_GROUPS), 0.01),
        'router_e_w': nrm((L, D, N_EXPERTS), D ** -0.5),
        'router_e_b': nrm((L, N_EXPERTS), 0.01),
        'moe_w_gate': nrm((L, N_EXPERTS, D, D_EXPERT), D ** -0.5),
        'moe_w_up': nrm((L, N_EXPERTS, D, D_EXPERT), D ** -0.5),
        'moe_w_down': nrm((L, N_EXPERTS, D_EXPERT, D), D_EXPERT ** -0.5),
        'final_g': 1.0 + nrm((D,), 0.02),
    }


def reference(x, c, positions, ln1_g, ln2_g, ada_w, ada_b, w_in, mla_q_norm, mla_kv_norm,
              mla_w_uq, mla_w_ukv, swa_sink, diff_lambda, diff_norm_g, hy_conv_w, hy_conv_b,
              hy_w1, hy_b1, hy_w2, hy_b2, hy_w3, hy_b3, hy_w4, hy_sin_freq, hy_bias, w_out,
              router_g_w, router_g_b, router_e_w, router_e_b, moe_w_gate, moe_w_up, moe_w_down,
              final_g):
    c_act = jax.nn.silu(c)
    split_at = [MLA_COLS, MLA_COLS + SWA_COLS, MLA_COLS + SWA_COLS + DIFF_COLS]
    for l in range(DEPTH):
        mod = (c_act @ ada_w[l] + ada_b[l])[:, None, :]
        sh1, sc1, g1, sh2, sc2, g2 = jnp.split(mod, 6, axis=-1)
        h = rms_norm(x, ln1_g[l]) * (1.0 + sc1) + sh1
        cols = h @ w_in[l]
        c_a, c_b, c_c, c_d = jnp.split(cols, split_at, axis=-1)
        y_a = mla_mixer(c_a, positions, mla_q_norm[l], mla_kv_norm[l], mla_w_uq[l], mla_w_ukv[l])
        y_b = swa_mixer(c_b, positions, swa_sink[l])
        lambda_init = 0.8 - 0.6 * math.exp(-0.3 * l)
        y_c = diff_mixer(c_c, positions, diff_lambda[l], diff_norm_g[l], lambda_init)
        y_d = hyena_mixer(c_d, hy_conv_w[l], hy_conv_b[l], hy_w1[l], hy_b1[l], hy_w2[l], hy_b2[l],
                          hy_w3[l], hy_b3[l], hy_w4[l], hy_sin_freq[l], hy_bias[l])
        mix = jnp.concatenate([y_a, y_b, y_c, y_d], axis=-1)
        x = x + g1 * (mix @ w_out[l])
        h = rms_norm(x, ln2_g[l]) * (1.0 + sc2) + sh2
        x = x + g2 * hier_moe(h, router_g_w[l], router_g_b[l], router_e_w[l], router_e_b[l],
                              moe_w_gate[l], moe_w_up[l], moe_w_down[l])
    return rms_norm(x, final_g)
```

```cpp
#include <hip/hip_runtime.h>
#include <stdint.h>
#include <stdio.h>
#include <type_traits>

#define DI __device__ __forceinline__
typedef unsigned short bf16_t;
typedef short bf16x8 __attribute__((ext_vector_type(8)));
typedef float f32x16 __attribute__((ext_vector_type(16)));
typedef float f32x4 __attribute__((ext_vector_type(4)));
typedef float f32x2 __attribute__((ext_vector_type(2)));
typedef unsigned u32x4 __attribute__((ext_vector_type(4)));
typedef unsigned u32x2 __attribute__((ext_vector_type(2)));
typedef __bf16 bf2_t __attribute__((ext_vector_type(2)));

#define MFMA32(a, b, c) __builtin_amdgcn_mfma_f32_32x32x16_bf16((a), (b), (c), 0, 0, 0)
#define COSREV(f) __builtin_amdgcn_cosf(f)
#define SINREV(f) __builtin_amdgcn_sinf(f)

constexpr int NB = 4, S = 8192, T = NB * S, D = 1024, NL = 4;
constexpr int INC = 2464, NPAD = 2560;
constexpr float EPS = 1e-6f;
constexpr float LOG2E = 1.4426950408889634f;
constexpr int NTHREADS = 256;
constexpr int GRID = 512;
constexpr int LDS_BYTES = 77824;
constexpr int PSLOTS = 65536 + 32 * 128;
constexpr int LCAP = 32768;

enum { I_X = 0, I_C, I_POS, I_LN1, I_LN2, I_ADAW, I_ADAB, I_WIN, I_QNORM, I_KVNORM, I_WUQ, I_WUKV, I_SINK, I_LAMBDA, I_DNORM,
       I_CONVW, I_CONVB, I_HW1, I_HB1, I_HW2, I_HB2, I_HW3, I_HB3, I_HW4, I_HFREQ, I_HBIAS, I_WOUT, I_RGW, I_RGB, I_REW, I_REB,
       I_MG, I_MU, I_MD, I_FINAL, N_IN };

constexpr size_t al256(size_t x) { return (x + 255) & ~(size_t)255; }
constexpr size_t OFF_CTRL = 0;
constexpr size_t OFF_MOD  = 65536;
constexpr size_t OFF_H3   = OFF_MOD + al256((size_t)NL * NB * 6144 * 4);
constexpr size_t OFF_WIN  = OFF_H3 + (size_t)NL * 8192 * 64 * 4;
constexpr size_t OFF_WOUT = OFF_WIN + (size_t)NL * NPAD * 1024 * 2;
constexpr size_t OFF_WUQ  = OFF_WOUT + (size_t)NL * 1024 * 1024 * 2;
constexpr size_t OFF_WUKV = OFF_WUQ + (size_t)NL * 384 * 256 * 2;
constexpr size_t OFF_WR   = OFF_WUKV + (size_t)NL * 512 * 128 * 2;
constexpr size_t OFF_WGU  = OFF_WR + (size_t)NL * 128 * 1024 * 2;
constexpr size_t OFF_WD   = OFF_WGU + (size_t)NL * 32 * 512 * 1024 * 2;
constexpr size_t OFF_H    = OFF_WD + (size_t)NL * 32 * 1024 * 256 * 2;
constexpr size_t OFF_TOKE = OFF_H + (size_t)T * 1024 * 2;
constexpr size_t OFF_TOKP = OFF_TOKE + (size_t)T * 2 * 4;
constexpr size_t OFF_LTOK = OFF_TOKP + (size_t)T * 2 * 4;
constexpr size_t OFF_LGATE= OFF_LTOK + (size_t)32 * LCAP * 4;
constexpr size_t OFF_OB   = OFF_LGATE + (size_t)32 * LCAP * 4;
constexpr size_t OFF_R1   = OFF_OB + (size_t)512 * 8192 * 8;
constexpr size_t OFF_CA   = OFF_R1;
constexpr size_t OFF_QM   = OFF_CA + (size_t)T * 512 * 2;
constexpr size_t OFF_KM   = OFF_QM + (size_t)16 * S * 96 * 2;
constexpr size_t OFF_VMT  = OFF_KM + (size_t)16 * S * 96 * 2;
constexpr size_t OFF_QS   = OFF_VMT + (size_t)16 * 64 * S * 2;
constexpr size_t OFF_KS   = OFF_QS + (size_t)16 * S * 64 * 2;
constexpr size_t OFF_VST  = OFF_KS + (size_t)8 * S * 64 * 2;
constexpr size_t OFF_QD   = OFF_VST + (size_t)8 * 64 * S * 2;
constexpr size_t OFF_KD   = OFF_QD + (size_t)16 * S * 64 * 2;
constexpr size_t OFF_VDT  = OFF_KD + (size_t)16 * S * 64 * 2;
constexpr size_t OFF_HY   = OFF_VDT + (size_t)16 * 64 * S * 2;
constexpr size_t OFF_MIX  = OFF_HY + (size_t)NB * 768 * S * 2;
constexpr size_t OFF_END  = OFF_MIX + (size_t)T * 1024 * 2;
constexpr size_t OFF_Y    = OFF_R1;
constexpr size_t OFF_ACT  = OFF_Y + (size_t)PSLOTS * 1024 * 2;
static_assert(OFF_ACT + (size_t)PSLOTS * 256 * 2 <= OFF_MIX, "MoE buffers must not overlap MIX");
constexpr size_t OFF_HYO  = OFF_END;
constexpr size_t WS_NEEDED = OFF_HYO + (size_t)NB * 256 * S * 2;

constexpr int CT_CNT = 0;
constexpr int CT_QHEAD = 256;

struct Params {
  const void* in[N_IN];
  float* out;
  char* ws;
};
typedef const __attribute__((address_space(4))) char* kptr_t;
typedef __attribute__((address_space(1))) char* gptr_t;
typedef gptr_t const __attribute__((address_space(4)))* kq_t;
struct KIn { kptr_t ka; DI const void* operator[](int i) const { return (const void*)(*(kq_t)(ka + 8 * i)); } };
struct PV { KIn in; float* out; char* ws; };
DI PV mkpv() {
  kptr_t ka = (kptr_t)__builtin_amdgcn_kernarg_segment_ptr();
  asm volatile("" : "+s"(ka));
  PV v; v.in.ka = ka; v.out = (float*)(*(kq_t)(ka + 8 * N_IN)); v.ws = (char*)(*(kq_t)(ka + 8 * (N_IN + 1)));
  return v;
}

DI float bf2f(bf16_t v) { return __uint_as_float(((unsigned)v) << 16); }
DI unsigned pack2(float a, float b) { bf2_t v; v.x = (__bf16)a; v.y = (__bf16)b; return __builtin_bit_cast(unsigned, v); }
DI bf16_t f2bf(float a) { return __builtin_bit_cast(bf16_t, (__bf16)a); }
DI float lo_bf(unsigned u) { return __uint_as_float(u << 16); }
DI float hi_bf(unsigned u) { return __uint_as_float(u & 0xffff0000u); }
DI int crow(int i, int h) { return (i & 3) + 8 * (i >> 2) + 4 * h; }
DI float shx(float v, int m, int lane) { return __builtin_bit_cast(float, __builtin_amdgcn_ds_bpermute((lane ^ m) << 2, __builtin_bit_cast(int, v))); }
DI float wave_sum(float v, int lane) {
  v += shx(v, 32, lane); v += shx(v, 16, lane); v += shx(v, 8, lane); v += shx(v, 4, lane); v += shx(v, 2, lane); v += shx(v, 1, lane);
  return v;
}
DI void sync_mem() { asm volatile("s_waitcnt vmcnt(0)" ::: "memory"); __syncthreads(); }
DI int my_tid(int wv) {
  int lane; asm volatile("v_mbcnt_lo_u32_b32 %0, -1, 0\n\tv_mbcnt_hi_u32_b32 %0, -1, %0" : "=v"(lane)); asm volatile("" : "+s"(wv)); return (wv << 6) | lane; }
DI float silu(float x) { return x / (1.0f + __expf(-x)); }
DI float fast_sin(float x) { return __builtin_amdgcn_sinf(__builtin_amdgcn_fractf(x * 0.15915494309189535f)); }
DI float fast_cos(float x) { return __builtin_amdgcn_cosf(__builtin_amdgcn_fractf(x * 0.15915494309189535f)); }
DI float rope_freq(int i, int half) { return expf((-9.210340371976184f * (float)i) / (float)half); }
DI void rope_sincos(float ps, int i, int half, float& sn, float& cs) {
  const float fr = __builtin_amdgcn_exp2f((-13.287712379549449f * (float)i) / (float)half) * 0.15915494309189535f;
  const float pr = ps * fr, er = __builtin_fmaf(ps, fr, -pr);
  const float rev = __builtin_amdgcn_fractf(pr) + er;
  sn = __builtin_amdgcn_sinf(rev); cs = __builtin_amdgcn_cosf(rev);
}

constexpr int LP = 72;

template <int BM, bool SWAP, class RowPtr, class Epi>
DI void gemm_tile(RowPtr rowptr, const bf16_t* __restrict__ Bt, int ldb, int K, char* smem, int tid, Epi epi) {
  constexpr int MI = BM / 64;
  constexpr int ACH = BM / 32;
  bf16_t* As = (bf16_t*)smem;
  bf16_t* Bs = As + 2 * BM * LP;
  const int lane = tid & 63, wid = tid >> 6, wm = wid >> 1, wn = wid & 1, r = lane & 31, h = lane >> 5;
  const int cr = tid >> 3, kc = tid & 7;
  const bf16_t* ap[ACH];
#pragma unroll
  for (int i = 0; i < ACH; ++i) ap[i] = rowptr(cr + 32 * i) + kc * 8;
  const bf16_t* bp = Bt + (size_t)cr * ldb + kc * 8;
  u32x4 ra0[ACH], rb0[4], ra1[ACH], rb1[4];
  f32x16 acc[MI][2];
#pragma unroll
  for (int mi = 0; mi < MI; ++mi)
#pragma unroll
    for (int ni = 0; ni < 2; ++ni)
#pragma unroll
      for (int i = 0; i < 16; ++i) acc[mi][ni][i] = 0.f;
  const int KT = K >> 6;
  auto gload = [&](u32x4 (&ra)[ACH], u32x4 (&rb)[4], int k0) {
#pragma unroll
    for (int i = 0; i < ACH; ++i) ra[i] = *(const u32x4*)(ap[i] + k0);
#pragma unroll
    for (int i = 0; i < 4; ++i) rb[i] = *(const u32x4*)(bp + (size_t)(32 * i) * ldb + k0);
  };
  auto lstore = [&](const u32x4 (&ra)[ACH], const u32x4 (&rb)[4], int buf) {
#pragma unroll
    for (int i = 0; i < ACH; ++i) *(u32x4*)(As + (buf * BM + cr + 32 * i) * LP + kc * 8) = ra[i];
#pragma unroll
    for (int i = 0; i < 4; ++i) *(u32x4*)(Bs + (buf * 128 + cr + 32 * i) * LP + kc * 8) = rb[i];
  };
  auto compute = [&](int buf) {
    const bf16_t* Ab = As + (buf * BM + wm * (BM / 2) + r) * LP + 8 * h;
    const bf16_t* Bb = Bs + (buf * 128 + wn * 64 + r) * LP + 8 * h;
    bf16x8 af[3][MI], bfr[3][2];
#pragma unroll
    for (int k0 = 0; k0 < 2; ++k0) {
#pragma unroll
      for (int mi = 0; mi < MI; ++mi) af[k0][mi] = *(const bf16x8*)(Ab + mi * 32 * LP + k0 * 16);
#pragma unroll
      for (int ni = 0; ni < 2; ++ni) bfr[k0][ni] = *(const bf16x8*)(Bb + ni * 32 * LP + k0 * 16);
    }
    __builtin_amdgcn_sched_group_barrier(0x100, 2 * (MI + 2), 0);
#pragma unroll
    for (int ks = 0; ks < 4; ++ks) {
      if (ks < 2) {
#pragma unroll
        for (int mi = 0; mi < MI; ++mi) af[(ks + 2) % 3][mi] = *(const bf16x8*)(Ab + mi * 32 * LP + (ks + 2) * 16);
#pragma unroll
        for (int ni = 0; ni < 2; ++ni) bfr[(ks + 2) % 3][ni] = *(const bf16x8*)(Bb + ni * 32 * LP + (ks + 2) * 16);
      }
#pragma unroll
      for (int mi = 0; mi < MI; ++mi)
#pragma unroll
        for (int ni = 0; ni < 2; ++ni)
          acc[mi][ni] = SWAP ? MFMA32(bfr[ks % 3][ni], af[ks % 3][mi], acc[mi][ni]) : MFMA32(af[ks % 3][mi], bfr[ks % 3][ni], acc[mi][ni]);
      if (ks < 2) __builtin_amdgcn_sched_group_barrier(0x100, MI + 2, 0);
      __builtin_amdgcn_sched_group_barrier(0x008, MI * 2, 0);
      if (ks == 1) __builtin_amdgcn_sched_group_barrier(0x200, ACH + 4, 0);
    }
  };
  gload(ra0, rb0, 0);
  gload(ra1, rb1, 64);
  lstore(ra0, rb0, 0);
  __syncthreads();
  for (int kt = 0; kt < KT; kt += 2) {
    if (kt + 2 < KT) gload(ra0, rb0, (kt + 2) << 6);
    compute(0);
    lstore(ra1, rb1, 1);
    __syncthreads();
    if (kt + 3 < KT) gload(ra1, rb1, (kt + 3) << 6);
    compute(1);
    if (kt + 2 < KT) lstore(ra0, rb0, 0);
    __syncthreads();
  }
  epi(acc, wm, wn, r, h);
}

typedef short v4i16_t __attribute__((ext_vector_type(4)));
DI int troff(int row, int ch) { return 256 * row + 16 * (ch ^ (((row & 3) << 2) | ((row >> 2) & 3))); }
DI bf16x8 tr_frag(const char* base, int o0, int o1) {
  const v4i16_t lo = __builtin_amdgcn_ds_read_tr16_b64_v4i16((__attribute__((address_space(3))) v4i16_t*)(base + o0));
  const v4i16_t hi = __builtin_amdgcn_ds_read_tr16_b64_v4i16((__attribute__((address_space(3))) v4i16_t*)(base + o1));
  bf16x8 r; r[0] = lo[0]; r[1] = lo[1]; r[2] = lo[2]; r[3] = lo[3]; r[4] = hi[0]; r[5] = hi[1]; r[6] = hi[2]; r[7] = hi[3]; return r;
}
template <class Epi>
DI void gemm_tile_l3a(const bf16_t* __restrict__ A, const bf16_t* __restrict__ Hy, const bf16_t* __restrict__ Bt, char* smem, int tid, Epi epi) {
  constexpr int BM = 128, MI = 2, ACH = 4, KT = 16, KS0 = 12, ldb = 1024;
  bf16_t* As = (bf16_t*)smem;
  bf16_t* Bs = As + 2 * BM * LP;
  const int lane = tid & 63, wid = tid >> 6, wm = wid >> 1, wn = wid & 1, r = lane & 31, h = lane >> 5;
  const int cr = tid >> 3, kc = tid & 7;
  const bf16_t* ap[ACH];
#pragma unroll
  for (int i = 0; i < ACH; ++i) ap[i] = A + (size_t)(cr + 32 * i) * 1024 + kc * 8;
  const bf16_t* bp = Bt + (size_t)cr * ldb + kc * 8;
  u32x4 ra0[ACH], rb0[4], ra1[ACH], rb1[4];
  f32x16 acc[MI][2];
#pragma unroll
  for (int mi = 0; mi < MI; ++mi)
#pragma unroll
    for (int ni = 0; ni < 2; ++ni)
#pragma unroll
      for (int i = 0; i < 16; ++i) acc[mi][ni][i] = 0.f;
  auto gload = [&](u32x4 (&ra)[ACH], u32x4 (&rb)[4], const int kt) {
    if (kt < KS0) {
#pragma unroll
      for (int i = 0; i < ACH; ++i) ra[i] = *(const u32x4*)(ap[i] + (kt << 6));
    } else {
#pragma unroll
      for (int i = 0; i < ACH; ++i) { const int pc = tid + 256 * i; ra[i] = *(const u32x4*)(Hy + (size_t)(((kt - KS0) << 6) + (pc >> 4)) * S + (pc & 15) * 8); }
    }
#pragma unroll
    for (int i = 0; i < 4; ++i) rb[i] = *(const u32x4*)(bp + (size_t)(32 * i) * ldb + (kt << 6));
  };
  auto lstore = [&](const u32x4 (&ra)[ACH], const u32x4 (&rb)[4], const int buf, const int kt) {
    if (kt < KS0) {
#pragma unroll
      for (int i = 0; i < ACH; ++i) *(u32x4*)(As + (buf * BM + cr + 32 * i) * LP + kc * 8) = ra[i];
    } else {
#pragma unroll
      for (int i = 0; i < ACH; ++i) { const int pc = tid + 256 * i; *(u32x4*)((char*)(As + buf * BM * LP) + troff(pc >> 4, pc & 15)) = ra[i]; }
    }
#pragma unroll
    for (int i = 0; i < 4; ++i) *(u32x4*)(Bs + (buf * 128 + cr + 32 * i) * LP + kc * 8) = rb[i];
  };
  auto compute = [&](const int buf, const int kt) {
    const bf16_t* Bb = Bs + (buf * 128 + wn * 64 + r) * LP + 8 * h;
    if (kt < KS0) {
      const bf16_t* Ab = As + (buf * BM + wm * (BM / 2) + r) * LP + 8 * h;
      bf16x8 af[3][MI], bfr[3][2];
#pragma unroll
      for (int k0 = 0; k0 < 2; ++k0) {
#pragma unroll
        for (int mi = 0; mi < MI; ++mi) af[k0][mi] = *(const bf16x8*)(Ab + mi * 32 * LP + k0 * 16);
#pragma unroll
        for (int ni = 0; ni < 2; ++ni) bfr[k0][ni] = *(const bf16x8*)(Bb + ni * 32 * LP + k0 * 16);
      }
      __builtin_amdgcn_sched_group_barrier(0x100, 2 * (MI + 2), 0);
#pragma unroll
      for (int ks = 0; ks < 4; ++ks) {
        if (ks < 2) {
#pragma unroll
          for (int mi = 0; mi < MI; ++mi) af[(ks + 2) % 3][mi] = *(const bf16x8*)(Ab + mi * 32 * LP + (ks + 2) * 16);
#pragma unroll
          for (int ni = 0; ni < 2; ++ni) bfr[(ks + 2) % 3][ni] = *(const bf16x8*)(Bb + ni * 32 * LP + (ks + 2) * 16);
        }
#pragma unroll
        for (int mi = 0; mi < MI; ++mi)
#pragma unroll
          for (int ni = 0; ni < 2; ++ni) acc[mi][ni] = MFMA32(af[ks % 3][mi], bfr[ks % 3][ni], acc[mi][ni]);
        if (ks < 2) __builtin_amdgcn_sched_group_barrier(0x100, MI + 2, 0);
        __builtin_amdgcn_sched_group_barrier(0x008, MI * 2, 0);
        if (ks == 1) __builtin_amdgcn_sched_group_barrier(0x200, ACH + 4, 0);
      }
    } else {
      const char* Ab = (const char*)(As + buf * BM * LP);
      const int gl = lane >> 4, q = (lane & 15) >> 2, pp = lane & 3;
#pragma unroll
      for (int ks = 0; ks < 4; ++ks) {
        bf16x8 af[MI], bfr[2];
#pragma unroll
        for (int mi = 0; mi < MI; ++mi) { const int row = ks * 16 + 8 * (gl >> 1) + q, ch = ((wm * 64 + mi * 32 + 16 * (gl & 1)) >> 3) + (pp >> 1);
          af[mi] = tr_frag(Ab, troff(row, ch) + 8 * (pp & 1), troff(row + 4, ch) + 8 * (pp & 1)); }
#pragma unroll
        for (int ni = 0; ni < 2; ++ni) bfr[ni] = *(const bf16x8*)(Bb + ni * 32 * LP + ks * 16);
#pragma unroll
        for (int mi = 0; mi < MI; ++mi)
#pragma unroll
          for (int ni = 0; ni < 2; ++ni) acc[mi][ni] = MFMA32(af[mi], bfr[ni], acc[mi][ni]);
      }
    }
  };
  gload(ra0, rb0, 0);
  gload(ra1, rb1, 1);
  lstore(ra0, rb0, 0, 0);
  __syncthreads();
#pragma unroll
  for (int kt = 0; kt < KT; kt += 2) {
    if (kt + 2 < KT) gload(ra0, rb0, kt + 2);
    compute(0, kt);
    lstore(ra1, rb1, 1, kt + 1);
    __syncthreads();
    if (kt + 3 < KT) gload(ra1, rb1, kt + 3);
    compute(1, kt + 1);
    if (kt + 2 < KT) lstore(ra0, rb0, 0, kt + 2);
    __syncthreads();
  }
  epi(acc, wm, wn, r, h);
}

DI int map_in(int n) {
  if (n < 384) return n;
  if (n < 512) return (n - 384) < 32 ? n : -1;
  if (n < 768) return 416 + (n - 512);
  if (n < 896) return 672 + (n - 768);
  if (n < 1024) return 800 + (n - 896);
  if (n < 1536) {
    const int isk = n >= 1280; const int loc = n - (isk ? 1280 : 1024);
    const int head = loc >> 6, within = loc & 63, nb = within >> 5, c = within & 31, which = c >> 4, idx = 16 * nb + (c & 15);
    return (isk ? 1184 : 928) + head * 64 + which * 32 + idx;
  }
  if (n < 1792) return 1440 + (n - 1536);
  return 1696 + (n - 1792);
}
DI int map_uq(int n) {
  if (n < 256) return (n >> 6) * 96 + (n & 63);
  const int loc = n - 256, wn = loc >> 6, within = loc & 63, nb = within >> 5, c = within & 31;
  const int head = 2 * wn + (c >> 4), idx = 16 * nb + (c & 15);
  return head * 96 + 64 + idx;
}
DI int map_ukv(int n) {
  if (n < 256) return (n >> 6) * 128 + (n & 63);
  const int loc = n - 256; return (loc >> 6) * 128 + 64 + (loc & 63);
}

template <class SrcF>
DI void tr_tile(SrcF src, bf16_t* dst, int dstK, int n0, int k0, char* smem, int tid) {
  bf16_t* t = (bf16_t*)smem;
  const int nn = tid & 63, kq = tid >> 6;
  float tv[16];
#pragma unroll
  for (int i = 0; i < 16; ++i) tv[i] = src(k0 + kq + 4 * i, n0 + nn);
#pragma unroll
  for (int i = 0; i < 16; ++i) t[nn * 66 + kq + 4 * i] = f2bf(tv[i]);
  __syncthreads();
  const int n2 = tid >> 2, q = tid & 3;
  const unsigned* tw = (const unsigned*)t;
  u32x4 a, b;
  a.x = tw[n2 * 33 + 8 * q + 0]; a.y = tw[n2 * 33 + 8 * q + 1]; a.z = tw[n2 * 33 + 8 * q + 2]; a.w = tw[n2 * 33 + 8 * q + 3];
  b.x = tw[n2 * 33 + 8 * q + 4]; b.y = tw[n2 * 33 + 8 * q + 5]; b.z = tw[n2 * 33 + 8 * q + 6]; b.w = tw[n2 * 33 + 8 * q + 7];
  bf16_t* d = dst + (size_t)(n0 + n2) * dstK + k0 + 16 * q;
  *(u32x4*)d = a; *(u32x4*)(d + 8) = b;
  __syncthreads();
}


template <int SSTRIDE, int DSTK, class F>
DI void tr_stream(int n_items, F decode, char* smem, int tid) {
  const int nn = tid & 63, kq = tid >> 6, n2 = tid >> 2, q = tid & 3;
  float tn[16];
  const float* sp; bf16_t* dp;
  int it = blockIdx.x;
  if (it < n_items) { decode(it, sp, dp, kq, nn, n2, q);
#pragma unroll
    for (int i = 0; i < 16; ++i) tn[i] = sp[(size_t)(4 * i) * SSTRIDE]; }
  int buf = 0;
#pragma unroll 1
  for (; it < n_items; it += gridDim.x, buf ^= 1) {
    float tv[16];
#pragma unroll
    for (int i = 0; i < 16; ++i) tv[i] = tn[i];
    bf16_t* dcur = dp;
    if (it + (int)gridDim.x < n_items) { decode(it + gridDim.x, sp, dp, kq, nn, n2, q);
#pragma unroll
      for (int i = 0; i < 16; ++i) tn[i] = sp[(size_t)(4 * i) * SSTRIDE]; }
    bf16_t* t = (bf16_t*)smem + buf * 64 * 66;
#pragma unroll
    for (int i = 0; i < 16; ++i) t[nn * 66 + kq + 4 * i] = f2bf(tv[i]);
    __syncthreads();
    const unsigned* tw = (const unsigned*)t;
    u32x4 a, b;
    a.x = tw[n2 * 33 + 8 * q + 0]; a.y = tw[n2 * 33 + 8 * q + 1]; a.z = tw[n2 * 33 + 8 * q + 2]; a.w = tw[n2 * 33 + 8 * q + 3];
    b.x = tw[n2 * 33 + 8 * q + 4]; b.y = tw[n2 * 33 + 8 * q + 5]; b.z = tw[n2 * 33 + 8 * q + 6]; b.w = tw[n2 * 33 + 8 * q + 7];
    *(u32x4*)dcur = a; *(u32x4*)(dcur + 8) = b;
  }
  __syncthreads();
}

constexpr int PA_ADA = NL * 96;
constexpr int PA_WIN = NL * 40 * 16;
constexpr int PA_WOUT = NL * 16 * 16;
constexpr int PA_WUQ = NL * 6 * 4;
constexpr int PA_WUKV = NL * 8 * 2;
constexpr int PA_WR = NL * 2 * 16;
constexpr int PA_WGU = NL * 32 * 8 * 16;
constexpr int PA_WD = NL * 32 * 16 * 4;
constexpr int PA_H3 = NL * 64;
constexpr int PA_GEN = PA_ADA + PA_H3 + PA_WIN + PA_WOUT + PA_WUQ + PA_WUKV + PA_WR;

DI void phase_pa(const PV& p, char* smem, int tid) {
  const int lane = tid & 63, wid = tid >> 6;
  for (int it0 = blockIdx.x; it0 < PA_GEN; it0 += gridDim.x) {
    int it = it0;
    if (it < PA_ADA) {
      const int l = it / 96, ch = it % 96;
      float* cact = (float*)smem; float* red = (float*)(smem + 16384);
      const float* cin = (const float*)p.in[I_C];
      for (int i = tid; i < NB * 1024; i += 256) cact[i] = silu(cin[i]);
      __syncthreads();
      const float* W = (const float*)p.in[I_ADAW] + (size_t)l * 1024 * 6144 + ch * 64 + lane;
      float a0 = 0.f, a1 = 0.f, a2 = 0.f, a3 = 0.f;
      const int kb = wid * 256;
#pragma unroll 32
      for (int k = 0; k < 256; ++k) {
        const float w = W[(size_t)(kb + k) * 6144];
        a0 += cact[kb + k] * w; a1 += cact[1024 + kb + k] * w; a2 += cact[2048 + kb + k] * w; a3 += cact[3072 + kb + k] * w;
      }
      red[(wid * 4 + 0) * 64 + lane] = a0; red[(wid * 4 + 1) * 64 + lane] = a1; red[(wid * 4 + 2) * 64 + lane] = a2; red[(wid * 4 + 3) * 64 + lane] = a3;
      __syncthreads();
      {
        const int b = tid >> 6;
        const float v = red[(0 * 4 + b) * 64 + lane] + red[(1 * 4 + b) * 64 + lane] + red[(2 * 4 + b) * 64 + lane] + red[(3 * 4 + b) * 64 + lane]
                      + ((const float*)p.in[I_ADAB])[l * 6144 + ch * 64 + lane];
        ((float*)(p.ws + OFF_MOD))[(size_t)(l * NB + b) * 6144 + ch * 64 + lane] = v;
      }
      __syncthreads();
      continue;
    }
    it -= PA_ADA;
    if (it < PA_H3) {
      const int l = it >> 6, pos = tid & 127, half = tid >> 7, n = (it & 63) * 128 + pos;
      float* hbuf = (float*)smem;
      float* Wl = (float*)(smem + 128 * 65 * 4);
      const float* w1 = (const float*)p.in[I_HW1] + l * 33 * 64; const float* b1 = (const float*)p.in[I_HB1] + l * 64;
      const float* w2 = (const float*)p.in[I_HW2] + l * 64 * 64; const float* b2 = (const float*)p.in[I_HB2] + l * 64;
      const float* w3 = (const float*)p.in[I_HW3] + l * 64 * 64; const float* b3 = (const float*)p.in[I_HB3] + l * 64;
      const float* fr = (const float*)p.in[I_HFREQ] + l * 3 * 64;
      const float tt = (float)n / 8191.0f;
      const float w = 6.283185307179586f * (float)n / 8192.0f;
      auto loadW = [&](const float* wsrc, int n4) { for (int i = tid; i < n4; i += 256) ((f32x4*)Wl)[i] = ((const f32x4*)wsrc)[i]; };
      float* hrow = hbuf + pos * 65;
      if (half == 0) { hrow[0] = tt;
        for (int i = 0; i < 16; ++i) { const float f = 1e-4f + (float)i * ((15.0f - 1e-4f) / 15.0f); hrow[1 + i] = fast_cos(w * f); } }
      else { for (int i = 0; i < 16; ++i) { const float f = 1e-4f + (float)i * ((15.0f - 1e-4f) / 15.0f); hrow[17 + i] = -fast_sin(w * f); } }
      loadW(w1, 33 * 16);
      __syncthreads();
      float acc[32];
      auto layer = [&](int rows, const float* bias) {
#pragma unroll
        for (int j = 0; j < 32; ++j) acc[j] = bias[half * 32 + j];
#pragma unroll 4
        for (int i = 0; i < rows; ++i) { const float xv = hrow[i]; const f32x4* wr = (const f32x4*)(Wl + i * 64 + half * 32);
#pragma unroll
          for (int q = 0; q < 8; ++q) { const f32x4 wv = wr[q]; acc[4 * q] += xv * wv.x; acc[4 * q + 1] += xv * wv.y; acc[4 * q + 2] += xv * wv.z; acc[4 * q + 3] += xv * wv.w; } }
      };
      layer(33, b1);
      __syncthreads();
#pragma unroll
      for (int j = 0; j < 32; ++j) hrow[half * 32 + j] = fast_sin(fr[half * 32 + j] * acc[j]);
      loadW(w2, 64 * 16);
      __syncthreads();
      layer(64, b2);
      __syncthreads();
#pragma unroll
      for (int j = 0; j < 32; ++j) hrow[half * 32 + j] = fast_sin(fr[64 + half * 32 + j] * acc[j]);
      loadW(w3, 64 * 16);
      __syncthreads();
      layer(64, b3);
      bf16_t* oh = (bf16_t*)(p.ws + OFF_H3) + ((size_t)l * 2 * 8192 + n) * 64 + half * 32;
      bf16_t* ol = oh + (size_t)8192 * 64;
#pragma unroll
      for (int g = 0; g < 4; ++g) { unsigned ph[4], pl[4];
#pragma unroll
        for (int j = 0; j < 4; ++j) { const int c = 8 * g + 2 * j;
          const float v0 = fast_sin(fr[128 + half * 32 + c] * acc[c]), v1 = fast_sin(fr[128 + half * 32 + c + 1] * acc[c + 1]);
          ph[j] = pack2(v0, v1); pl[j] = pack2(v0 - lo_bf(ph[j]), v1 - hi_bf(ph[j])); }
        u32x4 a; a.x = ph[0]; a.y = ph[1]; a.z = ph[2]; a.w = ph[3]; *(u32x4*)(oh + 8 * g) = a;
        u32x4 bq; bq.x = pl[0]; bq.y = pl[1]; bq.z = pl[2]; bq.w = pl[3]; *(u32x4*)(ol + 8 * g) = bq; }
      __syncthreads();
      continue;
    }
    it -= PA_H3;
    if (it < PA_WIN) {
      const int l = it / 640, rem = it % 640, nt = rem >> 4, kt = rem & 15;
      const float* W = (const float*)p.in[I_WIN] + (size_t)l * 1024 * INC;
      tr_tile([&](int k, int n) { const int sc = map_in(n); return sc >= 0 ? W[(size_t)k * INC + sc] : 0.f; },
              (bf16_t*)(p.ws + OFF_WIN) + (size_t)l * NPAD * 1024, 1024, nt * 64, kt * 64, smem, tid);
      continue;
    }
    it -= PA_WIN;
    if (it < PA_WOUT) {
      const int l = it >> 8, rem = it & 255, nt = rem >> 4, kt = rem & 15;
      const float* W = (const float*)p.in[I_WOUT] + (size_t)l * 1024 * 1024;
      tr_tile([&](int k, int n) { return W[(size_t)k * 1024 + n]; }, (bf16_t*)(p.ws + OFF_WOUT) + (size_t)l * 1024 * 1024, 1024, nt * 64, kt * 64, smem, tid);
      continue;
    }
    it -= PA_WOUT;
    if (it < PA_WUQ) {
      const int l = it / 24, rem = it % 24, nt = rem >> 2, kt = rem & 3;
      const float* W = (const float*)p.in[I_WUQ] + (size_t)l * 256 * 384;
      const float* g = (const float*)p.in[I_QNORM] + l * 256;
      tr_tile([&](int k, int n) { return W[(size_t)k * 384 + map_uq(n)] * g[k]; }, (bf16_t*)(p.ws + OFF_WUQ) + (size_t)l * 384 * 256, 256, nt * 64, kt * 64, smem, tid);
      continue;
    }
    it -= PA_WUQ;
    if (it < PA_WUKV) {
      const int l = it >> 4, rem = it & 15, nt = rem >> 1, kt = rem & 1;
      const float* W = (const float*)p.in[I_WUKV] + (size_t)l * 128 * 512;
      const float* g = (const float*)p.in[I_KVNORM] + l * 128;
      tr_tile([&](int k, int n) { return W[(size_t)k * 512 + map_ukv(n)] * g[k]; }, (bf16_t*)(p.ws + OFF_WUKV) + (size_t)l * 512 * 128, 128, nt * 64, kt * 64, smem, tid);
      continue;
    }
    it -= PA_WUKV;
    if (it < PA_WR) {
      const int l = it >> 5, rem = it & 31, nt = rem >> 4, kt = rem & 15;
      const float* Wg = (const float*)p.in[I_RGW] + (size_t)l * 1024 * 4;
      const float* We = (const float*)p.in[I_REW] + (size_t)l * 1024 * 32;
      tr_tile([&](int k, int n) { return n < 4 ? Wg[(size_t)k * 4 + n] : (n < 36 ? We[(size_t)k * 32 + (n - 4)] : 0.f); },
              (bf16_t*)(p.ws + OFF_WR) + (size_t)l * 128 * 1024, 1024, nt * 64, kt * 64, smem, tid);
      continue;
    }
  }
  tr_stream<256, 1024>(PA_WGU, [&](int it, const float*& sp, bf16_t*& dp, int kq, int nn, int n2, int q) {
    const int le = it >> 7, rem = it & 127, nt = rem >> 4, kt = rem & 15;
    const int n = nt * 64 + nn; const int j = n >> 7, qq = (n >> 5) & 3, c = n & 31; const int col = 64 * j + 32 * (qq >> 1) + c;
    const float* W = (qq & 1) ? (const float*)p.in[I_MU] : (const float*)p.in[I_MG];
    sp = W + (size_t)le * 1024 * 256 + (size_t)(kt * 64 + kq) * 256 + col;
    dp = (bf16_t*)(p.ws + OFF_WGU) + (size_t)le * 512 * 1024 + (size_t)(nt * 64 + n2) * 1024 + kt * 64 + 16 * q; }, smem, tid);
  tr_stream<1024, 256>(PA_WD, [&](int it, const float*& sp, bf16_t*& dp, int kq, int nn, int n2, int q) {
    const int le = it >> 6, rem = it & 63, nt = rem >> 2, kt = rem & 3;
    sp = (const float*)p.in[I_MD] + (size_t)le * 256 * 1024 + (size_t)(kt * 64 + kq) * 1024 + nt * 64 + nn;
    dp = (bf16_t*)(p.ws + OFF_WD) + (size_t)le * 1024 * 256 + (size_t)(nt * 64 + n2) * 256 + kt * 64 + 16 * q; }, smem, tid);
}

DI void moe_bases(const unsigned* cnt, int* lbase  , int tid) {
  if (tid == 0) { int acc = 0; for (int e = 0; e < 32; ++e) { lbase[e] = acc; acc += ((int)cnt[e] + 127) & ~127; } lbase[32] = acc; }
  __syncthreads();
}

template <bool FINAL>
DI void phase_l0(const PV& p, int l, char* smem, int tid) {
  const int lane = tid & 63, wid = tid >> 6;
  int* lbase = (int*)smem;
  const unsigned* ctrl = (const unsigned*)(p.ws + OFF_CTRL);
  if (l > 0) moe_bases(ctrl + CT_CNT + (l - 1) * 32, lbase, tid);
  const float* mod = (const float*)(p.ws + OFF_MOD);
  const float* xin = (const float*)p.in[I_X];
  float* xres = p.out;
  bf16_t* XB = (bf16_t*)p.out;
  const bf16_t* Y = (const bf16_t*)(p.ws + OFF_Y);
  const int* toke = (const int*)(p.ws + OFF_TOKE);
  const int* tokp = (const int*)(p.ws + OFF_TOKP);
  bf16_t* H = (bf16_t*)(p.ws + OFF_H);
  const float* gw = FINAL ? (const float*)p.in[I_FINAL] : (const float*)p.in[I_LN1] + l * 1024;
  for (int row = blockIdx.x * 4 + wid; row < T; row += gridDim.x * 4) {
    const int b = row >> 13;
    f32x4 xv[4];
    if (l == 0) {
#pragma unroll
      for (int i = 0; i < 4; ++i) xv[i] = *(const f32x4*)(xin + (size_t)row * 1024 + lane * 4 + 256 * i);
    } else {
      const int e0 = toke[row * 2], e1 = toke[row * 2 + 1];
      const size_t s0 = (size_t)(lbase[e0] + tokp[row * 2]), s1 = (size_t)(lbase[e1] + tokp[row * 2 + 1]);
      const float* g2 = mod + (size_t)((l - 1) * NB + b) * 6144 + 5 * 1024;
#pragma unroll
      for (int i = 0; i < 4; ++i) {
        const int c = lane * 4 + 256 * i;
        const u32x2 xb = *(const u32x2*)(XB + (size_t)row * 2048 + c);
        f32x4 xr; xr.x = lo_bf(xb.x); xr.y = hi_bf(xb.x); xr.z = lo_bf(xb.y); xr.w = hi_bf(xb.y);
        const u32x2 y0 = *(const u32x2*)(Y + s0 * 1024 + c), y1 = *(const u32x2*)(Y + s1 * 1024 + c);
        const f32x4 g = *(const f32x4*)(g2 + c);
        xr.x += g.x * (lo_bf(y0.x) + lo_bf(y1.x)); xr.y += g.y * (hi_bf(y0.x) + hi_bf(y1.x));
        xr.z += g.z * (lo_bf(y0.y) + lo_bf(y1.y)); xr.w += g.w * (hi_bf(y0.y) + hi_bf(y1.y));
        xv[i] = xr;
      }
    }
    float ss = 0.f;
#pragma unroll
    for (int i = 0; i < 4; ++i) ss += xv[i].x * xv[i].x + xv[i].y * xv[i].y + xv[i].z * xv[i].z + xv[i].w * xv[i].w;
    ss = wave_sum(ss, lane);
    const float rstd = rsqrtf(ss * (1.0f / 1024.0f) + EPS);
    if (FINAL) {
#pragma unroll
      for (int i = 0; i < 4; ++i) {
        const int c = lane * 4 + 256 * i; const f32x4 g = *(const f32x4*)(gw + c);
        f32x4 o; o.x = xv[i].x * rstd * g.x; o.y = xv[i].y * rstd * g.y; o.z = xv[i].z * rstd * g.z; o.w = xv[i].w * rstd * g.w;
        *(f32x4*)(xres + (size_t)row * 1024 + c) = o;
      }
    } else {
      const float* sh = mod + (size_t)(l * NB + b) * 6144; const float* sc = sh + 1024;
#pragma unroll
      for (int i = 0; i < 4; ++i) {
        const int c = lane * 4 + 256 * i;
        { u32x2 xo; xo.x = pack2(xv[i].x, xv[i].y); xo.y = pack2(xv[i].z, xv[i].w); *(u32x2*)(XB + (size_t)row * 2048 + c) = xo; }
        const f32x4 g = *(const f32x4*)(gw + c), s1 = *(const f32x4*)(sc + c), s0 = *(const f32x4*)(sh + c);
        const float h0 = xv[i].x * rstd * g.x * (1.f + s1.x) + s0.x, h1 = xv[i].y * rstd * g.y * (1.f + s1.y) + s0.y;
        const float h2 = xv[i].z * rstd * g.z * (1.f + s1.z) + s0.z, h3 = xv[i].w * rstd * g.w * (1.f + s1.w) + s0.w;
        u32x2 o; o.x = pack2(h0, h1); o.y = pack2(h2, h3);
        *(u32x2*)(H + (size_t)row * 1024 + c) = o;
      }
    }
  }
}

DI void store4_bf(bf16_t* dst, float a, float b, float c, float d) { u32x2 o; o.x = pack2(a, b); o.y = pack2(c, d); *(u32x2*)dst = o; }

DI unsigned xcc_id() { return (unsigned)__builtin_amdgcn_s_getreg((3 << 11) | 20) & 0x7u; }
template <class NF, class F>
DI void xcd_queue_run(unsigned* qheads, char* smem, int wv, NF nitems, F f) {
  int* slot = (int*)(smem + LDS_BYTES - 16);
  const unsigned myx = xcc_id();
  for (int tries = 0; tries < 8;) {
    const unsigned x = (myx + tries) & 7u;
    const int n = nitems((int)x);
    __syncthreads();
    if (my_tid(wv) == 0) *slot = (int)atomicAdd(&qheads[x * 64], 1u);
    __syncthreads();
    const int idx = __builtin_amdgcn_readfirstlane(*slot);
    if (idx >= n) { ++tries; continue; }
    const int t = my_tid(wv);
    f((int)x, idx, t);
  }
}

DI void phase_l1(const PV& p, int l, char* smem, int wv) {
  const bf16_t* H = (const bf16_t*)(p.ws + OFF_H);
  const bf16_t* W = (const bf16_t*)(p.ws + OFF_WIN) + (size_t)l * NPAD * 1024;
  const int* pos = (const int*)p.in[I_POS];
  bf16_t* CA = (bf16_t*)(p.ws + OFF_CA);
  bf16_t* QS = (bf16_t*)(p.ws + OFF_QS); bf16_t* KS = (bf16_t*)(p.ws + OFF_KS); bf16_t* VST = (bf16_t*)(p.ws + OFF_VST);
  bf16_t* QD = (bf16_t*)(p.ws + OFF_QD); bf16_t* KD = (bf16_t*)(p.ws + OFF_KD); bf16_t* VDT = (bf16_t*)(p.ws + OFF_VDT);
  bf16_t* HY = (bf16_t*)(p.ws + OFF_HY);
  xcd_queue_run((unsigned*)(p.ws + OFF_CTRL) + CT_QHEAD + l * 8 * 64 + 1, smem, wv, [](int) { return 640; }, [&](int x, int idx, int tid) {
    const int mg = idx / 160, rem = idx % 160; const int nt = rem >> 3, mt = x * 32 + mg * 8 + (rem & 7);
    const int m0 = mt * 128;
    const bf16_t* A = H + (size_t)m0 * 1024;
    auto rowptr = [&](int row) { return A + (size_t)row * 1024; };
    const bf16_t* Bt = W + (size_t)nt * 128 * 1024;
    const bool transposed = (nt == 7) || (nt >= 12);
    float psv[2];
    { const int rw = m0 + ((tid >> 7) & 1) * 64 + (tid & 31); psv[0] = (float)pos[rw]; psv[1] = (float)pos[rw + 32]; }
    if (!transposed) {
      gemm_tile<128, true>(rowptr, Bt, 1024, 1024, smem, tid, [&](f32x16 (&acc)[2][2], int wm, int wn, int r, int h) {
        if (nt < 4) {
#pragma unroll
          for (int mi = 0; mi < 2; ++mi) { const int tok = m0 + wm * 64 + mi * 32 + r;
#pragma unroll
            for (int ni = 0; ni < 2; ++ni)
#pragma unroll
              for (int g = 0; g < 4; ++g)
                store4_bf(CA + (size_t)tok * 512 + nt * 128 + wn * 64 + ni * 32 + 8 * g + 4 * h, acc[mi][ni][4 * g], acc[mi][ni][4 * g + 1], acc[mi][ni][4 * g + 2], acc[mi][ni][4 * g + 3]);
          }
        } else if (nt < 7) {
          const bool isq = nt < 6; const int head = isq ? (nt - 4) * 2 + wn : wn; const float scl = isq ? 0.125f * LOG2E : 1.0f;
#pragma unroll
          for (int mi = 0; mi < 2; ++mi) { const int tok = m0 + wm * 64 + mi * 32 + r; const int b = tok >> 13, s = tok & 8191; const float ps = psv[mi];
            bf16_t* dst = isq ? QS + ((size_t)(b * 4 + head) * S + s) * 64 : KS + ((size_t)(b * 2 + head) * S + s) * 64;
#pragma unroll
            for (int g = 0; g < 4; ++g) { float o1[4], o2[4];
#pragma unroll
              for (int e = 0; e < 4; ++e) { const int c = 8 * g + 4 * h + e; float sn, cs; rope_sincos(ps, c, 32, sn, cs);
                const float x1 = acc[mi][0][4 * g + e], x2 = acc[mi][1][4 * g + e]; o1[e] = (x1 * cs - x2 * sn) * scl; o2[e] = (x1 * sn + x2 * cs) * scl; }
              store4_bf(dst + 8 * g + 4 * h, o1[0], o1[1], o1[2], o1[3]); store4_bf(dst + 32 + 8 * g + 4 * h, o2[0], o2[1], o2[2], o2[3]); }
          }
        } else {
          const bool isq = nt < 10; const int head = (isq ? nt - 8 : nt - 10) * 2 + wn; const float scl = isq ? 0.17677669529663687f * LOG2E : 1.0f;
#pragma unroll
          for (int mi = 0; mi < 2; ++mi) { const int tok = m0 + wm * 64 + mi * 32 + r; const int b = tok >> 13, s = tok & 8191; const float ps = psv[mi];
            bf16_t* dst = (isq ? QD : KD) + ((size_t)(b * 4 + head) * S + s) * 64;
#pragma unroll
            for (int g = 0; g < 4; ++g) { float o1[4], o2[4]; const int which = g >> 1;
#pragma unroll
              for (int e = 0; e < 4; ++e) { const int i = 8 * (g & 1) + 4 * h + e; float sn, cs; rope_sincos(ps, i, 16, sn, cs);
                const float x1 = acc[mi][0][4 * g + e], x2 = acc[mi][1][4 * g + e]; o1[e] = (x1 * cs - x2 * sn) * scl; o2[e] = (x1 * sn + x2 * cs) * scl; }
              const int i0 = 8 * (g & 1) + 4 * h;
              store4_bf(dst + which * 32 + i0, o1[0], o1[1], o1[2], o1[3]); store4_bf(dst + which * 32 + 16 + i0, o2[0], o2[1], o2[2], o2[3]); }
          }
        }
      });
    } else {
      gemm_tile<128, false>(rowptr, Bt, 1024, 1024, smem, tid, [&](f32x16 (&acc)[2][2], int wm, int wn, int r, int h) {
#pragma unroll
        for (int mi = 0; mi < 2; ++mi) { const int tb = m0 + wm * 64 + mi * 32; const int b = tb >> 13, sb = tb & 8191;
#pragma unroll
          for (int ni = 0; ni < 2; ++ni) {
            bf16_t* dst; bool perm = true;
            if (nt == 7) dst = VST + ((size_t)(b * 2 + wn) * 64 + ni * 32 + r) * S + sb;
            else if (nt < 14) dst = VDT + ((size_t)(b * 4 + (nt - 12) * 2 + wn) * 64 + ni * 32 + r) * S + sb;
            else { dst = HY + ((size_t)b * 768 + (nt - 14) * 128 + wn * 64 + ni * 32 + r) * S + sb; perm = false; }
#pragma unroll
            for (int g = 0; g < 4; ++g) {
              const int off = perm ? 16 * (g >> 1) + 8 * h + 4 * (g & 1) : 8 * g + 4 * h;
              store4_bf(dst + off, acc[mi][ni][4 * g], acc[mi][ni][4 * g + 1], acc[mi][ni][4 * g + 2], acc[mi][ni][4 * g + 3]);
            }
          }
        }
      });
    }
  });
}

DI void phase_l1b(const PV& p, int l, char* smem, int tid) {
  const bf16_t* CA = (const bf16_t*)(p.ws + OFF_CA);
  const bf16_t* WUQ = (const bf16_t*)(p.ws + OFF_WUQ) + (size_t)l * 384 * 256;
  const bf16_t* WUKV = (const bf16_t*)(p.ws + OFF_WUKV) + (size_t)l * 512 * 128;
  const int* pos = (const int*)p.in[I_POS];
  bf16_t* QM = (bf16_t*)(p.ws + OFF_QM); bf16_t* KM = (bf16_t*)(p.ws + OFF_KM); bf16_t* VMT = (bf16_t*)(p.ws + OFF_VMT);
  float* rq = (float*)(smem + 73728); float* rkv = rq + 64;
  const float qscl = 0.10206207261596577f * LOG2E;
  for (int mt = blockIdx.x; mt < 512; mt += gridDim.x) {
    const int m0 = mt * 64;
    {
      const int row = tid >> 2, q = tid & 3, lane = tid & 63;
      const bf16_t* src = CA + (size_t)(m0 + row) * 512;
      float s1 = 0.f, s2 = 0.f;
#pragma unroll
      for (int i = 0; i < 8; ++i) { const u32x4 v = *(const u32x4*)(src + q * 64 + i * 8);
        s1 += lo_bf(v.x) * lo_bf(v.x) + hi_bf(v.x) * hi_bf(v.x) + lo_bf(v.y) * lo_bf(v.y) + hi_bf(v.y) * hi_bf(v.y) + lo_bf(v.z) * lo_bf(v.z) + hi_bf(v.z) * hi_bf(v.z) + lo_bf(v.w) * lo_bf(v.w) + hi_bf(v.w) * hi_bf(v.w); }
#pragma unroll
      for (int i = 0; i < 4; ++i) { const u32x4 v = *(const u32x4*)(src + 256 + q * 32 + i * 8);
        s2 += lo_bf(v.x) * lo_bf(v.x) + hi_bf(v.x) * hi_bf(v.x) + lo_bf(v.y) * lo_bf(v.y) + hi_bf(v.y) * hi_bf(v.y) + lo_bf(v.z) * lo_bf(v.z) + hi_bf(v.z) * hi_bf(v.z) + lo_bf(v.w) * lo_bf(v.w) + hi_bf(v.w) * hi_bf(v.w); }
      s1 += shx(s1, 1, lane); s1 += shx(s1, 2, lane); s2 += shx(s2, 1, lane); s2 += shx(s2, 2, lane);
      if (q == 0) { rq[row] = rsqrtf(s1 * (1.0f / 256.0f) + EPS); rkv[row] = rsqrtf(s2 * (1.0f / 128.0f) + EPS); }
    }
    __syncthreads();
    const bf16_t* A = CA + (size_t)m0 * 512;
    for (int nt = 0; nt < 3; ++nt) {
      gemm_tile<64, true>([&](int row) { return A + (size_t)row * 512; }, WUQ + (size_t)nt * 128 * 256, 256, 256, smem, tid,
        [&](f32x16 (&acc)[1][2], int wm, int wn, int r, int h) {
          const int lrow = wm * 32 + r, tok = m0 + lrow; const int b = tok >> 13, s = tok & 8191; const float sc = rq[lrow] * qscl;
          if (nt < 2) { const int head = nt * 2 + wn; bf16_t* dst = QM + ((size_t)(b * 4 + head) * S + s) * 96;
#pragma unroll
            for (int ni = 0; ni < 2; ++ni)
#pragma unroll
              for (int g = 0; g < 4; ++g) store4_bf(dst + ni * 32 + 8 * g + 4 * h, acc[0][ni][4 * g] * sc, acc[0][ni][4 * g + 1] * sc, acc[0][ni][4 * g + 2] * sc, acc[0][ni][4 * g + 3] * sc);
          } else { const float ps = (float)pos[tok];
#pragma unroll
            for (int g = 0; g < 4; ++g) { const int head = 2 * wn + (g >> 1); bf16_t* dst = QM + ((size_t)(b * 4 + head) * S + s) * 96 + 64; float o1[4], o2[4];
#pragma unroll
              for (int e = 0; e < 4; ++e) { const int i = 8 * (g & 1) + 4 * h + e; float sn, cs; rope_sincos(ps, i, 16, sn, cs);
                const float x1 = acc[0][0][4 * g + e] * sc, x2 = acc[0][1][4 * g + e] * sc; o1[e] = x1 * cs - x2 * sn; o2[e] = x1 * sn + x2 * cs; }
              const int i0 = 8 * (g & 1) + 4 * h;
              store4_bf(dst + i0, o1[0], o1[1], o1[2], o1[3]); store4_bf(dst + 16 + i0, o2[0], o2[1], o2[2], o2[3]); }
          }
        });
    }
    for (int nt = 0; nt < 2; ++nt) {
      gemm_tile<64, true>([&](int row) { return A + (size_t)row * 512 + 256; }, WUKV + (size_t)nt * 128 * 128, 128, 128, smem, tid,
        [&](f32x16 (&acc)[1][2], int wm, int wn, int r, int h) {
          const int lrow = wm * 32 + r, tok = m0 + lrow; const int b = tok >> 13, s = tok & 8191; const float sc = rkv[lrow];
          const int head = nt * 2 + wn; bf16_t* dst = KM + ((size_t)(b * 4 + head) * S + s) * 96;
#pragma unroll
          for (int ni = 0; ni < 2; ++ni)
#pragma unroll
            for (int g = 0; g < 4; ++g) store4_bf(dst + ni * 32 + 8 * g + 4 * h, acc[0][ni][4 * g] * sc, acc[0][ni][4 * g + 1] * sc, acc[0][ni][4 * g + 2] * sc, acc[0][ni][4 * g + 3] * sc);
        });
    }
    for (int nt = 2; nt < 4; ++nt) {
      gemm_tile<64, false>([&](int row) { return A + (size_t)row * 512 + 256; }, WUKV + (size_t)nt * 128 * 128, 128, 128, smem, tid,
        [&](f32x16 (&acc)[1][2], int wm, int wn, int r, int h) {
          const int tb = m0 + wm * 32; const int b = tb >> 13, sb = tb & 8191; const int head = (nt - 2) * 2 + wn;
#pragma unroll
          for (int ni = 0; ni < 2; ++ni) { bf16_t* dst = VMT + ((size_t)(b * 4 + head) * 64 + ni * 32 + r) * S + sb;
#pragma unroll
            for (int g = 0; g < 4; ++g) { const float* rk = rkv + wm * 32 + 8 * g + 4 * h;
              store4_bf(dst + 16 * (g >> 1) + 8 * h + 4 * (g & 1), acc[0][ni][4 * g] * rk[0], acc[0][ni][4 * g + 1] * rk[1], acc[0][ni][4 * g + 2] * rk[2], acc[0][ni][4 * g + 3] * rk[3]); }
          }
        });
    }
#pragma unroll
    for (int j = 0; j < 4; ++j) {
      const int idx = tid + 256 * j, lrow = idx >> 4, i = idx & 15, tok = m0 + lrow; const int b = tok >> 13, s = tok & 8191;
      const float x1 = bf2f(CA[(size_t)tok * 512 + 384 + i]), x2 = bf2f(CA[(size_t)tok * 512 + 400 + i]);
      float sn, cs; rope_sincos((float)pos[tok], i, 16, sn, cs);
      const bf16_t o1 = f2bf(x1 * cs - x2 * sn), o2 = f2bf(x1 * sn + x2 * cs);
#pragma unroll
      for (int hd = 0; hd < 4; ++hd) { bf16_t* dst = KM + ((size_t)(b * 4 + hd) * S + s) * 96 + 64; dst[i] = o1; dst[16 + i] = o2; }
    }
    __syncthreads();
  }
}

DI float vmaxq(float a, float b) { return __builtin_amdgcn_fmed3f(a, b, __builtin_inff()); }

template <int DQ, int NMAP, bool BAND>
DI void attn_core(const bf16_t* __restrict__ Q, const bf16_t* __restrict__ K, const bf16_t* __restrict__ Vt, int q0, int k_lo, int k_hi,
                  float m_init, float l_init, f32x16 (&O)[NMAP][2], float (&lsum)[NMAP], char* smem, int tid) {
  constexpr int DK = DQ / NMAP, KS = DK / 16, PK = DQ + 8, KCH = DQ / 8 * 64 / 256;
  bf16_t* Ks = (bf16_t*)smem;
  bf16_t* Vs = Ks + 2 * 64 * PK;
  const int lane = tid & 63, wid = tid >> 6, r = lane & 31, h = lane >> 5;
  bf16x8 qf[DQ / 16];
  { const bf16_t* qp = Q + (size_t)(q0 + wid * 32 + r) * DQ + 8 * h;
#pragma unroll
    for (int ks = 0; ks < DQ / 16; ++ks) qf[ks] = *(const bf16x8*)(qp + ks * 16); }
  float m[NMAP];
  f32x16 negm[NMAP];
#pragma unroll
  for (int mp = 0; mp < NMAP; ++mp) { m[mp] = m_init; lsum[mp] = (h == 0) ? l_init : 0.f;
#pragma unroll
    for (int d = 0; d < 2; ++d)
#pragma unroll
      for (int i = 0; i < 16; ++i) O[mp][d][i] = 0.f; }
  u32x4 rk[KCH], rv[2];
  const int vrow = tid >> 3, vkc = tid & 7;
  auto gload = [&](int kt0) {
#pragma unroll
    for (int i = 0; i < KCH; ++i) rk[i] = *(const u32x4*)(K + (size_t)kt0 * DQ + (size_t)(tid + 256 * i) * 8);
#pragma unroll
    for (int i = 0; i < 2; ++i) rv[i] = *(const u32x4*)(Vt + (size_t)(vrow + 32 * i) * S + kt0 + vkc * 8);
  };
  auto lstore = [&](int buf) {
#pragma unroll
    for (int i = 0; i < KCH; ++i) { const int c = tid + 256 * i, row = c / (DQ / 8), kc = c % (DQ / 8); *(u32x4*)(Ks + (buf * 64 + row) * PK + kc * 8) = rk[i]; }
#pragma unroll
    for (int i = 0; i < 2; ++i) *(u32x4*)(Vs + (buf * 64 + vrow + 32 * i) * 72 + vkc * 8) = rv[i];
  };
  const int qpos = q0 + wid * 32 + r;
  auto tile = [&](int kt0, int buf, auto first_tag) {
    constexpr bool FIRST = decltype(first_tag)::value;
    const bf16_t* Kb = Ks + (buf * 64 + r) * PK + 8 * h;
    const bf16_t* Vb = Vs + (buf * 64 + r) * 72 + 8 * h;
#pragma unroll
    for (int mp = 0; mp < NMAP; ++mp) {
      f32x16 sc[2];
      auto qk = [&]() {
#pragma unroll
        for (int kb = 0; kb < 2; ++kb) {
          if (FIRST) {
#pragma unroll
            for (int i = 0; i < 16; ++i) sc[kb][i] = 0.f;
          } else sc[kb] = negm[mp];
#pragma unroll
          for (int ks = 0; ks < KS; ++ks) { const bf16x8 kf = *(const bf16x8*)(Kb + kb * 32 * PK + (mp * KS + ks) * 16); sc[kb] = MFMA32(kf, qf[mp * KS + ks], sc[kb]); }
        }
        if (BAND) {
#pragma unroll
          for (int kb = 0; kb < 2; ++kb)
#pragma unroll
            for (int i = 0; i < 16; ++i) { const int dlt = kt0 + kb * 32 + crow(i, h) - qpos; if (dlt > 128 || dlt < -128) sc[kb][i] = -1e30f; }
        }
      };
      auto expsum = [&]() {
        f32x2 ps2a = {0.f, 0.f}, ps2b = {0.f, 0.f};
#pragma unroll
        for (int kb = 0; kb < 2; ++kb)
#pragma unroll
          for (int i = 0; i < 16; i += 2) { const f32x2 pv = {__builtin_amdgcn_exp2f(sc[kb][i]), __builtin_amdgcn_exp2f(sc[kb][i + 1])}; sc[kb][i] = pv.x; sc[kb][i + 1] = pv.y;
            if (i & 2) ps2a += pv; else ps2b += pv; }
        const f32x2 t = ps2a + ps2b; return t.x + t.y;
      };
      qk();
      float ps;
      if (FIRST) {
        float mx = vmaxq(sc[0][0], sc[1][0]);
#pragma unroll
        for (int i = 1; i < 16; ++i) mx = vmaxq(vmaxq(mx, sc[0][i]), sc[1][i]);
        mx = fmaxf(mx, shx(mx, 32, lane));
        const float mnew = fmaxf(m[mp], mx);
        lsum[mp] *= __builtin_amdgcn_exp2f(m[mp] - mnew);
        m[mp] = mnew;
#pragma unroll
        for (int i = 0; i < 16; ++i) { negm[mp][i] = -mnew; sc[0][i] -= mnew; sc[1][i] -= mnew; }
        ps = expsum();
      } else {
        ps = expsum();
        if (__builtin_amdgcn_ballot_w64(!(ps <= 65536.0f)) != 0ull) {
          qk();
          float mx = vmaxq(sc[0][0], sc[1][0]);
#pragma unroll
          for (int i = 1; i < 16; ++i) mx = vmaxq(vmaxq(mx, sc[0][i]), sc[1][i]);
          mx = fmaxf(mx, shx(mx, 32, lane));
          const float dl = fmaxf(mx, 0.f);
          const float alpha = __builtin_amdgcn_exp2f(-dl);
          m[mp] += dl; lsum[mp] *= alpha;
#pragma unroll
          for (int i = 0; i < 16; ++i) { negm[mp][i] -= dl; sc[0][i] -= dl; sc[1][i] -= dl; }
#pragma unroll
          for (int d = 0; d < 2; ++d)
#pragma unroll
            for (int i = 0; i < 16; ++i) O[mp][d][i] *= alpha;
          ps = expsum();
        }
      }
      lsum[mp] += ps;
#pragma unroll
      for (int kb = 0; kb < 2; ++kb)
#pragma unroll
        for (int s2 = 0; s2 < 2; ++s2) {
          u32x4 pw; pw.x = pack2(sc[kb][8 * s2 + 0], sc[kb][8 * s2 + 1]); pw.y = pack2(sc[kb][8 * s2 + 2], sc[kb][8 * s2 + 3]);
          pw.z = pack2(sc[kb][8 * s2 + 4], sc[kb][8 * s2 + 5]); pw.w = pack2(sc[kb][8 * s2 + 6], sc[kb][8 * s2 + 7]);
          const bf16x8 pf = __builtin_bit_cast(bf16x8, pw);
#pragma unroll
          for (int d = 0; d < 2; ++d) { const bf16x8 vf = *(const bf16x8*)(Vb + d * 32 * 72 + kb * 32 + s2 * 16); O[mp][d] = MFMA32(vf, pf, O[mp][d]); }
        }
    }
  };
  gload(k_lo); lstore(0); __syncthreads();
  {
    const bool more = k_lo + 64 < k_hi;
    if (more) gload(k_lo + 64);
    tile(k_lo, 0, std::true_type{});
    if (more) lstore(1);
    __syncthreads();
  }
  int buf = 1;
  for (int kt0 = k_lo + 64; kt0 < k_hi; kt0 += 64, buf ^= 1) {
    const bool more = kt0 + 64 < k_hi;
    if (more) gload(kt0 + 64);
    tile(kt0, buf, std::false_type{});
    if (more) lstore(buf ^ 1);
    __syncthreads();
  }
#pragma unroll
  for (int mp = 0; mp < NMAP; ++mp) lsum[mp] += shx(lsum[mp], 32, lane);
}

template <int DQ, bool BAND>
DI void attn_core_pipe(const bf16_t* __restrict__ Q, const bf16_t* __restrict__ K, const bf16_t* __restrict__ Vt, int q0, int k_lo, int k_hi,
                       float m_init, float l_init, f32x16 (&O)[2], float& lsum_out, char* smem, int tid) {
  constexpr int KS = DQ / 16, PK = DQ + 8, KCH = DQ / 8 * 64 / 256;
  bf16_t* Ks = (bf16_t*)smem;
  bf16_t* Vs = Ks + 2 * 64 * PK;
  const int lane = tid & 63, wid = tid >> 6, r = lane & 31, h = lane >> 5;
  bf16x8 qf[KS];
  { const bf16_t* qp = Q + (size_t)(q0 + wid * 32 + r) * DQ + 8 * h;
#pragma unroll
    for (int ks = 0; ks < KS; ++ks) qf[ks] = *(const bf16x8*)(qp + ks * 16); }
  float m = m_init, lsum = (h == 0) ? l_init : 0.f;
  f32x16 negm;
#pragma unroll
  for (int d = 0; d < 2; ++d)
#pragma unroll
    for (int i = 0; i < 16; ++i) O[d][i] = 0.f;
  u32x4 rk[KCH], rv[2];
  const int vrow = tid >> 3, vkc = tid & 7;
  auto gloadK = [&](int kt0) {
#pragma unroll
    for (int i = 0; i < KCH; ++i) rk[i] = *(const u32x4*)(K + (size_t)kt0 * DQ + (size_t)(tid + 256 * i) * 8);
  };
  auto gloadV = [&](int kt0) {
#pragma unroll
    for (int i = 0; i < 2; ++i) rv[i] = *(const u32x4*)(Vt + (size_t)(vrow + 32 * i) * S + kt0 + vkc * 8);
  };
  auto lstoreK = [&](int buf) {
#pragma unroll
    for (int i = 0; i < KCH; ++i) { const int c = tid + 256 * i, row = c / (DQ / 8), kc = c % (DQ / 8); *(u32x4*)(Ks + (buf * 64 + row) * PK + kc * 8) = rk[i]; }
  };
  auto lstoreV = [&](int buf) {
#pragma unroll
    for (int i = 0; i < 2; ++i) *(u32x4*)(Vs + (buf * 64 + vrow + 32 * i) * 72 + vkc * 8) = rv[i];
  };
  auto qk = [&](f32x16 (&sc)[2], int buf, bool zero = false) {
    const bf16_t* Kb = Ks + (buf * 64 + r) * PK + 8 * h;
    bf16x8 kf[2][KS];
#pragma unroll
    for (int ks = 0; ks < KS; ++ks) kf[0][ks] = *(const bf16x8*)(Kb + ks * 16);
#pragma unroll
    for (int ks = 0; ks < KS; ++ks) kf[1][ks] = *(const bf16x8*)(Kb + 32 * PK + ks * 16);
    __builtin_amdgcn_sched_barrier(0);
#pragma unroll
    for (int kb = 0; kb < 2; ++kb) {
      if (zero) {
#pragma unroll
        for (int i = 0; i < 16; ++i) sc[kb][i] = 0.f;
      } else sc[kb] = negm;
#pragma unroll
      for (int ks = 0; ks < KS; ++ks) sc[kb] = MFMA32(kf[kb][ks], qf[ks], sc[kb]);
    }
  };
  const int qpos = q0 + wid * 32 + r;
  auto mask = [&](f32x16 (&sc)[2], int kt0) {
    if (BAND) {
#pragma unroll
      for (int kb = 0; kb < 2; ++kb)
#pragma unroll
        for (int i = 0; i < 16; ++i) { const int dlt = kt0 + kb * 32 + crow(i, h) - qpos; if (dlt > 128 || dlt < -128) sc[kb][i] = -1e30f; }
    }
  };
  auto expsum = [&](f32x16 (&sc)[2]) {
    f32x2 ps2a = {0.f, 0.f}, ps2b = {0.f, 0.f};
#pragma unroll
    for (int kb = 0; kb < 2; ++kb)
#pragma unroll
      for (int i = 0; i < 16; i += 2) { const f32x2 pv = {__builtin_amdgcn_exp2f(sc[kb][i]), __builtin_amdgcn_exp2f(sc[kb][i + 1])}; sc[kb][i] = pv.x; sc[kb][i + 1] = pv.y;
        if (i & 2) ps2a += pv; else ps2b += pv; }
    const f32x2 t = ps2a + ps2b; return t.x + t.y;
  };
  auto smpv = [&](f32x16 (&sc)[2], f32x16 (&nxt)[2], bool has1, int kt0, int buf) {
    mask(sc, kt0);
    if (has1) qk(nxt, buf ^ 1);
    float ps = expsum(sc);
    if (__builtin_amdgcn_ballot_w64(!(ps <= 65536.0f)) != 0ull) {
      {
        const bf16_t* Kg = K + (size_t)(kt0 + r) * DQ + 8 * h;
#pragma unroll
        for (int kb = 0; kb < 2; ++kb) { sc[kb] = negm;
#pragma unroll
          for (int ks = 0; ks < KS; ++ks) { const bf16x8 kf = *(const bf16x8*)(Kg + (size_t)kb * 32 * DQ + ks * 16); sc[kb] = MFMA32(kf, qf[ks], sc[kb]); } }
      }
      mask(sc, kt0);
      float mx = vmaxq(sc[0][0], sc[1][0]);
#pragma unroll
      for (int i = 1; i < 16; ++i) mx = vmaxq(vmaxq(mx, sc[0][i]), sc[1][i]);
      mx = fmaxf(mx, shx(mx, 32, lane));
      const float dl = fmaxf(mx, 0.f);
      const float alpha = __builtin_amdgcn_exp2f(-dl);
      m += dl; lsum *= alpha;
#pragma unroll
      for (int i = 0; i < 16; ++i) { negm[i] -= dl; sc[0][i] -= dl; sc[1][i] -= dl; }
      if (has1) {
#pragma unroll
        for (int i = 0; i < 16; ++i) { nxt[0][i] -= dl; nxt[1][i] -= dl; }
      }
#pragma unroll
      for (int d = 0; d < 2; ++d)
#pragma unroll
        for (int i = 0; i < 16; ++i) O[d][i] *= alpha;
      ps = expsum(sc);
    }
    lsum += ps;
    const bf16_t* Vb = Vs + (buf * 64 + r) * 72 + 8 * h;
    bf16x8 vf[2][2][2];
#pragma unroll
    for (int kb = 0; kb < 2; ++kb)
#pragma unroll
      for (int s2 = 0; s2 < 2; ++s2)
#pragma unroll
        for (int d = 0; d < 2; ++d) vf[kb][s2][d] = *(const bf16x8*)(Vb + d * 32 * 72 + kb * 32 + s2 * 16);
#pragma unroll
    for (int kb = 0; kb < 2; ++kb)
#pragma unroll
      for (int s2 = 0; s2 < 2; ++s2) {
        u32x4 pw; pw.x = pack2(sc[kb][8 * s2 + 0], sc[kb][8 * s2 + 1]); pw.y = pack2(sc[kb][8 * s2 + 2], sc[kb][8 * s2 + 3]);
        pw.z = pack2(sc[kb][8 * s2 + 4], sc[kb][8 * s2 + 5]); pw.w = pack2(sc[kb][8 * s2 + 6], sc[kb][8 * s2 + 7]);
        const bf16x8 pf = __builtin_bit_cast(bf16x8, pw);
#pragma unroll
        for (int d = 0; d < 2; ++d) O[d] = MFMA32(vf[kb][s2][d], pf, O[d]);
      }
    __builtin_amdgcn_sched_group_barrier(0x100, 8, 0);
#pragma unroll
    for (int g = 0; g < 4; ++g) { __builtin_amdgcn_sched_group_barrier(0x002, 4, 0); __builtin_amdgcn_sched_group_barrier(0x008, 2, 0); }
  };
  gloadK(k_lo); gloadV(k_lo); lstoreK(0); lstoreV(0);
  if (k_lo + 64 < k_hi) { gloadK(k_lo + 64); lstoreK(1); }
  __syncthreads();
  f32x16 scA[2], scB[2];
  qk(scA, 0, true);
  {
    mask(scA, k_lo);
    float mx = vmaxq(scA[0][0], scA[1][0]);
#pragma unroll
    for (int i = 1; i < 16; ++i) mx = vmaxq(vmaxq(mx, scA[0][i]), scA[1][i]);
    mx = fmaxf(mx, shx(mx, 32, lane));
    const float mnew = fmaxf(m, mx);
    lsum *= __builtin_amdgcn_exp2f(m - mnew);
    m = mnew;
#pragma unroll
    for (int i = 0; i < 16; ++i) { negm[i] = -mnew; scA[0][i] -= mnew; scA[1][i] -= mnew; }
  }
  __syncthreads();
  auto step = [&](f32x16 (&cur)[2], f32x16 (&nxt)[2], int kt0, int par, bool first) {
    const bool has1 = kt0 + 64 < k_hi, has2 = kt0 + 128 < k_hi;
    if (has2) gloadK(kt0 + 128);
    if (has1) gloadV(kt0 + 64);
    smpv(cur, nxt, has1, kt0, par);
    if (has2) lstoreK(par);
    if (has1) lstoreV(par ^ 1);
    __syncthreads();
  };
  step(scA, scB, k_lo, 0, true);
  int kt0 = k_lo + 64;
  for (; kt0 + 64 < k_hi; kt0 += 128) { step(scB, scA, kt0, 1, false); step(scA, scB, kt0 + 64, 0, false); }
  if (kt0 < k_hi) step(scB, scA, kt0, 1, false);
  lsum += shx(lsum, 32, lane);
  lsum_out = lsum;
}

DI void attn_store(bf16_t* MIX, int tok, int coloff, const f32x16 (&O)[2], float scale, int h) {
#pragma unroll
  for (int d = 0; d < 2; ++d)
#pragma unroll
    for (int g = 0; g < 4; ++g)
      store4_bf(MIX + (size_t)tok * 1024 + coloff + d * 32 + 8 * g + 4 * h, O[d][4 * g] * scale, O[d][4 * g + 1] * scale, O[d][4 * g + 2] * scale, O[d][4 * g + 3] * scale);
}

DI void mla_item(const PV& p, int bh, int qb, char* smem, int tid) {
  const bf16_t* Q = (const bf16_t*)(p.ws + OFF_QM) + (size_t)bh * S * 96;
  const bf16_t* K = (const bf16_t*)(p.ws + OFF_KM) + (size_t)bh * S * 96;
  const bf16_t* Vt = (const bf16_t*)(p.ws + OFF_VMT) + (size_t)bh * 64 * S;
  f32x16 O[1][2]; float ls[1];
  attn_core_pipe<96, false>(Q, K, Vt, qb * 128, 0, S, -INFINITY, 0.f, O[0], ls[0], smem, tid);
  const int lane = tid & 63, wid = tid >> 6, r = lane & 31, h = lane >> 5;
  const int b = bh >> 2, hd = bh & 3;
  attn_store((bf16_t*)(p.ws + OFF_MIX), b * S + qb * 128 + wid * 32 + r, hd * 64, O[0], 1.0f / ls[0], h);
}

DI void swa_item(const PV& p, int l, int bh, int qb, char* smem, int tid) {
  const int b = bh >> 2, hd = bh & 3, hk = hd >> 1;
  const bf16_t* Q = (const bf16_t*)(p.ws + OFF_QS) + (size_t)bh * S * 64;
  const bf16_t* K = (const bf16_t*)(p.ws + OFF_KS) + (size_t)(b * 2 + hk) * S * 64;
  const bf16_t* Vt = (const bf16_t*)(p.ws + OFF_VST) + (size_t)(b * 2 + hk) * 64 * S;
  const int q0 = qb * 128;
  const int k_lo = q0 - 128 < 0 ? 0 : q0 - 128, k_hi = q0 + 256 > S ? S : q0 + 256;
  const float sink = ((const float*)p.in[I_SINK])[l * 4 + hd] * LOG2E;
  f32x16 O[1][2]; float ls[1];
  attn_core_pipe<64, true>(Q, K, Vt, q0, k_lo, k_hi, sink, 1.0f, O[0], ls[0], smem, tid);
  const int lane = tid & 63, wid = tid >> 6, r = lane & 31, h = lane >> 5;
  attn_store((bf16_t*)(p.ws + OFF_MIX), b * S + q0 + wid * 32 + r, 256 + hd * 64, O[0], 1.0f / ls[0], h);
}

DI void diff_item(const PV& p, int l, int bh, int qb, char* smem, int tid) {
  const bf16_t* Q = (const bf16_t*)(p.ws + OFF_QD) + (size_t)bh * S * 64;
  const bf16_t* K = (const bf16_t*)(p.ws + OFF_KD) + (size_t)bh * S * 64;
  const bf16_t* Vt = (const bf16_t*)(p.ws + OFF_VDT) + (size_t)bh * 64 * S;
  f32x16 O[2][2]; float ls[2];
  attn_core<64, 2, false>(Q, K, Vt, qb * 128, 0, S, -INFINITY, 0.f, O, ls, smem, tid);
  const int lane = tid & 63, wid = tid >> 6, r = lane & 31, h = lane >> 5;
  const int b = bh >> 2, hd = bh & 3;
  asm volatile("" : "+s"(l));
  const float* lv = (const float*)p.in[I_LAMBDA] + l * 128;
  float d01 = 0.f, d23 = 0.f;
  for (int i = 0; i < 32; ++i) { d01 += lv[i] * lv[32 + i]; d23 += lv[64 + i] * lv[96 + i]; }
  const float lambda_init = 0.8f - 0.6f * expf(-0.3f * (float)l);
  const float lam = expf(d01) - expf(d23) + lambda_init;
  const float i1 = 1.0f / ls[0], i2 = lam / ls[1];
  const float* ng = (const float*)p.in[I_DNORM] + l * 64;
  f32x16 o[2]; float ss = 0.f;
#pragma unroll
  for (int d = 0; d < 2; ++d)
#pragma unroll
    for (int i = 0; i < 16; ++i) { const float v = O[0][d][i] * i1 - O[1][d][i] * i2; o[d][i] = v; ss += v * v; }
  ss += shx(ss, 32, lane);
  const float rstd = rsqrtf(ss * (1.0f / 64.0f) + EPS) * (1.0f - lambda_init);
#pragma unroll
  for (int d = 0; d < 2; ++d)
#pragma unroll
    for (int i = 0; i < 16; ++i) o[d][i] *= ng[d * 32 + crow(i, h)];
  attn_store((bf16_t*)(p.ws + OFF_MIX), b * S + qb * 128 + wid * 32 + r, 512 + hd * 64, o, rstd, h);
}

typedef float v2 __attribute__((ext_vector_type(2)));
typedef float v4 __attribute__((ext_vector_type(4)));
constexpr int FN = 8192;
constexpr int XPAD = 9216;
DI v2 mk2(float x, float y) { v2 r; r.x = x; r.y = y; return r; }
DI v2 cmul(v2 a, v2 t) { return __builtin_elementwise_fma(a.yy, mk2(-t.y, t.x), a.xx * t); }
DI v2 cmulc(v2 a, v2 t) { return __builtin_elementwise_fma(a.yy, mk2(t.y, t.x), a.xx * mk2(t.x, -t.y)); }
DI v2 twid2(float frac) { return mk2(COSREV(frac), -SINREV(frac)); }
DI v2 twidc2(float frac) { return mk2(COSREV(frac), SINREV(frac)); }
DI int xaddr(int i) { return (i + ((i >> 7) << 4)) ^ (((i >> 5) & 7) << 1); }

struct Tw8 { v2 t00, t01, t02, t03, t10, t11, t2; };
DI Tw8 tw8(float frac) {
  const float r = 0.70710678118654752f;
  const v2 w = twid2(frac), w2 = cmul(w, w), w4 = cmul(w2, w2);
  Tw8 t; t.t00 = w; t.t01 = mk2((w.x + w.y) * r, (w.y - w.x) * r); t.t02 = mk2(w.y, -w.x); t.t03 = mk2((w.y - w.x) * r, -(w.x + w.y) * r);
  t.t10 = w2; t.t11 = mk2(w2.y, -w2.x); t.t2 = w4; return t;
}
template <bool INV> DI void bfly(v2& a, v2& b, v2 t) {
  if (!INV) { const v2 s = a + b, d = a - b; a = s; b = cmul(d, t); }
  else { const v2 u = cmulc(b, t); const v2 s = a + u; b = a - u; a = s; }
}
template <bool INV> DI void fft8(v2 (&v)[8], const Tw8& t) {
  if (!INV) {
    bfly<false>(v[0], v[4], t.t00); bfly<false>(v[1], v[5], t.t01); bfly<false>(v[2], v[6], t.t02); bfly<false>(v[3], v[7], t.t03);
    bfly<false>(v[0], v[2], t.t10); bfly<false>(v[1], v[3], t.t11); bfly<false>(v[4], v[6], t.t10); bfly<false>(v[5], v[7], t.t11);
    bfly<false>(v[0], v[1], t.t2); bfly<false>(v[2], v[3], t.t2); bfly<false>(v[4], v[5], t.t2); bfly<false>(v[6], v[7], t.t2);
  } else {
    bfly<true>(v[0], v[1], t.t2); bfly<true>(v[2], v[3], t.t2); bfly<true>(v[4], v[5], t.t2); bfly<true>(v[6], v[7], t.t2);
    bfly<true>(v[0], v[2], t.t10); bfly<true>(v[1], v[3], t.t11); bfly<true>(v[4], v[6], t.t10); bfly<true>(v[5], v[7], t.t11);
    bfly<true>(v[0], v[4], t.t00); bfly<true>(v[1], v[5], t.t01); bfly<true>(v[2], v[6], t.t02); bfly<true>(v[3], v[7], t.t03);
  }
}
DI v2 mulw16(v2 a, int e, bool conj) {
  const float c1 = 0.92387953251128674f, s1 = 0.38268343236508977f, r = 0.70710678118654752f;
  if (e == 0) return a;
  if (e == 4) return conj ? mk2(-a.y, a.x) : mk2(a.y, -a.x);
  float cx, sy;
  if (e == 1) { cx = c1; sy = s1; } else if (e == 2) { cx = r; sy = r; } else if (e == 3) { cx = s1; sy = c1; }
  else if (e == 5) { cx = -s1; sy = c1; } else if (e == 6) { cx = -r; sy = r; } else { cx = -c1; sy = s1; }
  const float cy = conj ? sy : -sy;
  return __builtin_elementwise_fma(a.yy, mk2(-cy, cx), a.xx * mk2(cx, cy));
}
DI void fft16_fwd(v2 (&v)[16]) {
#pragma unroll
  for (int r = 0; r < 4; ++r) {
    const int hk = 16 >> (r + 1);
#pragma unroll
    for (int k = 0; k < 16; ++k) if ((k & hk) == 0) {
      const int e = (k & (hk - 1)) << r;
      const v2 a = v[k], b = v[k + hk];
      v[k] = a + b; v[k + hk] = mulw16(a - b, e, false);
    }
  }
}
DI void fft16_inv(v2 (&v)[16]) {
#pragma unroll
  for (int r = 3; r >= 0; --r) {
    const int hk = 16 >> (r + 1);
#pragma unroll
    for (int k = 0; k < 16; ++k) if ((k & hk) == 0) {
      const int e = (k & (hk - 1)) << r;
      const v2 a = v[k], u = mulw16(v[k + hk], e, true);
      v[k] = a + u; v[k + hk] = a - u;
    }
  }
}

template <int P, bool INV, int HOOK, class LDG, class XF>
DI void fpass(v2* X, int tid, LDG ldg, XF xf) {
  v2 pre[4][8];
  if constexpr (HOOK != 0) {
    int tq = tid; asm volatile("" : "+v"(tq));
#pragma unroll
    for (int gi = 0; gi < 4; ++gi)
#pragma unroll
      for (int k = 0; k < 8; ++k) pre[gi][k] = ldg(tq + 256 * gi + 1024 * k);
  }
  auto body = [&](const int gi) __attribute__((always_inline)) {
    int g = tid + 256 * gi; asm volatile("" : "+v"(g));
    int a0, a1 = 0, a2 = 0, a3 = 0; float frac;
    if (P == 0) { a0 = (g + ((g >> 7) << 4)) ^ (((g >> 5) & 7) << 1); frac = (float)g * (1.0f / 8192.0f); }
    else if (P == 1) { const int gl = g & 127; a0 = (1152 * (g >> 7) + gl) ^ (((gl >> 5) & 3) << 1); a1 = a0 ^ 8; frac = (float)gl * (1.0f / 1024.0f); }
    else { const int pp = (g & 15) ^ (((g >> 4) & 1) << 3), b = 144 * (g >> 4); a0 = b + pp; a1 = b + (pp ^ 2); a2 = b + (pp ^ 4); a3 = b + (pp ^ 6);
           frac = (float)(g & 15) * (1.0f / 128.0f); }
    auto addr = [&](int k) __attribute__((always_inline)) { return P == 0 ? a0 + 1152 * k : P == 1 ? ((k & 1) ? a1 : a0) + 144 * k : ((k >> 1) == 0 ? a0 : (k >> 1) == 1 ? a1 : (k >> 1) == 2 ? a2 : a3) + 16 * k; };
    v2 v[8];
    if constexpr (HOOK != 0 && !INV) {
#pragma unroll
      for (int k = 0; k < 8; ++k) v[k] = xf(g + 1024 * k, pre[gi][k]);
    } else {
#pragma unroll
      for (int k = 0; k < 8; ++k) v[k] = X[addr(k)];
    }
    const Tw8 t = tw8(frac);
    fft8<INV>(v, t);
    if constexpr (HOOK != 0 && INV) {
#pragma unroll
      for (int k = 0; k < 8; ++k) xf(g + 1024 * k, v[k], pre[gi][k]);
    } else {
#pragma unroll
      for (int k = 0; k < 8; ++k) X[addr(k)] = v[k];
    }
  };
  if constexpr (HOOK != 0) { body(0); body(1); body(2); body(3); }
  else {
#pragma unroll 2
    for (int gi = 0; gi < 4; ++gi) body(gi);
  }
}
template <int P, bool INV> DI void fpass_lds(v2* X, int tid) { fpass<P, INV, 0>(X, tid, [](int) { return mk2(0.f, 0.f); }, [](int, v2) { return mk2(0.f, 0.f); }); }

template <int MODE>
DI void fmid16(v2* X, int tid, const v4* Gt, v4* Dst, float scl) {
#pragma unroll
  for (int gi = 0; gi < 2; ++gi) {
    int g = tid + 256 * gi; asm volatile("" : "+v"(g));
    v4 gq[8];
    if (MODE == 0) {
#pragma unroll
      for (int c = 0; c < 8; ++c) gq[c] = Gt[c * 512 + g];
    }
    const int rb = ((16 * g + 16 * (g >> 3)) << 3) + (((g >> 1) & 7) << 4);
    v2 v[16];
#pragma unroll
    for (int c = 0; c < 8; ++c) { const v4 q = *(const v4*)((const char*)X + (rb ^ (c << 4))); v[2 * c] = q.xy; v[2 * c + 1] = q.zw; }
    fft16_fwd(v);
    if (MODE == 0) {
#pragma unroll
      for (int c = 0; c < 8; ++c) { v[2 * c] = cmul(v[2 * c], gq[c].xy); v[2 * c + 1] = cmul(v[2 * c + 1], gq[c].zw); }
      fft16_inv(v);
#pragma unroll
      for (int c = 0; c < 8; ++c) { v4 q; q.xy = v[2 * c]; q.zw = v[2 * c + 1]; *(v4*)((char*)X + (rb ^ (c << 4))) = q; }
    } else {
#pragma unroll
      for (int c = 0; c < 8; ++c) { v4 q; q.xy = v[2 * c] * scl; q.zw = v[2 * c + 1] * scl; Dst[c * 512 + g] = q; }
    }
  }
}

DI float conv3(const bf16_t* row, int n, float w0, float w1, float w2, float bb) {
  const int nm = n > 0 ? n - 1 : 0, np = n < S - 1 ? n + 1 : S - 1;
  float a = bf2f(row[nm]); const float b = bf2f(row[n]); float c = bf2f(row[np]);
  a = n > 0 ? a : 0.f; c = n < S - 1 ? c : 0.f;
  return w0 * a + w1 * b + w2 * c + bb;
}

DI void hyena_spectra(const PV& p, int l, int c, char* smem, int tid) {
  v2* X = (v2*)smem;
  float* red = (float*)(smem + XPAD * 8);
  const int lane = tid & 63, wid = tid >> 6, r = lane & 31, h = lane >> 5;
  const bf16_t* hh = (const bf16_t*)(p.ws + OFF_H3) + (size_t)l * 2 * 8192 * 64;
  const bf16_t* hl = hh + (size_t)8192 * 64;
  const float* w4 = (const float*)p.in[I_HW4] + (size_t)l * 64 * 1024;
  v4* SPEC = (v4*)((float2*)(p.ws + OFF_H) + (size_t)c * 4 * FN);
  float* T0 = (float*)((float2*)(p.ws + OFF_CA) + (size_t)blockIdx.x * FN);
  float* T1 = (float*)((float2*)(p.ws + OFF_OB) + (size_t)blockIdx.x * FN);
  const float decay = fabsf(-3.0701134573253945f + (float)c * ((-15.350567286626973f + 3.0701134573253945f) / 255.0f));
  {
    bf16x8 wh[4], wq[4];
    const int wcol = (r & 1) * 512 + ((r >> 1) & 1) * 256 + c;
#pragma unroll
    for (int ks = 0; ks < 4; ++ks) {
      unsigned ph[4], pl[4];
#pragma unroll
      for (int j = 0; j < 4; ++j) {
        float v0 = 0.f, v1 = 0.f;
        if (r < 4) { v0 = w4[(size_t)(ks * 16 + 8 * h + 2 * j) * 1024 + wcol]; v1 = w4[(size_t)(ks * 16 + 8 * h + 2 * j + 1) * 1024 + wcol]; }
        ph[j] = pack2(v0, v1);
        pl[j] = pack2(v0 - lo_bf(ph[j]), v1 - hi_bf(ph[j]));
      }
      u32x4 a; a.x = ph[0]; a.y = ph[1]; a.z = ph[2]; a.w = ph[3]; wh[ks] = __builtin_bit_cast(bf16x8, a);
      u32x4 b; b.x = pl[0]; b.y = pl[1]; b.z = pl[2]; b.w = pl[3]; wq[ks] = __builtin_bit_cast(bf16x8, b);
    }
#pragma unroll 2
    for (int i = 0; i < 64; ++i) {
      const int pos = (wid + 4 * i) * 32 + r;
      const bf16_t* rh = hh + (size_t)pos * 64 + 8 * h; const bf16_t* rl = hl + (size_t)pos * 64 + 8 * h;
      bf16x8 bh[4], bl[4];
#pragma unroll
      for (int ks = 0; ks < 4; ++ks) { bh[ks] = *(const bf16x8*)(rh + ks * 16); bl[ks] = *(const bf16x8*)(rl + ks * 16); }
      f32x16 acc;
#pragma unroll
      for (int q = 0; q < 16; ++q) acc[q] = 0.f;
#pragma unroll
      for (int ks = 0; ks < 4; ++ks) { acc = MFMA32(wh[ks], bh[ks], acc); acc = MFMA32(wh[ks], bl[ks], acc); acc = MFMA32(wq[ks], bh[ks], acc); }
      if (h == 0) { const float win = expf(-((float)pos / 8191.0f) * decay);
        T0[pos] = acc[0] * win; T0[8192 + pos] = acc[1] * win; T1[pos] = acc[2] * win; T1[8192 + pos] = acc[3] * win; }
    }
  }
  sync_mem();
#pragma unroll 1
  for (int o = 0; o < 2; ++o) {
    const float* Tf = o == 0 ? T0 : T1; const float* Tb = Tf + 8192;
    int t2 = tid; asm volatile("" : "+v"(t2));
    float ss = 0.f;
#pragma unroll 8
    for (int i = 0; i < 32; ++i) { const int n = t2 + 256 * i;
      const float f = Tf[n], bn = Tb[n], bm = Tb[(8192 - n) & 8191];
      float e; if (n == 0) { e = f + bn; ss += e * e; } else { e = f + bm; ss += f * f + bn * bn; }
      X[xaddr(n)] = mk2(e, 0.f); }
    ss = wave_sum(ss, lane);
    if (lane == 0) red[wid] = ss;
    __syncthreads();
    const float scl = rsqrtf(red[0] + red[1] + red[2] + red[3] + EPS) * (0.5f / 8192.0f);
    fpass_lds<0, false>(X, tid); __syncthreads(); fpass_lds<1, false>(X, tid); __syncthreads(); fpass_lds<2, false>(X, tid); __syncthreads();
    fmid16<1>(X, tid, nullptr, SPEC + (size_t)(o * 2 + 0) * (FN / 2), scl);
    __syncthreads();
    asm volatile("" : "+v"(t2));
#pragma unroll 8
    for (int i = 0; i < 32; ++i) { const int n = t2 + 256 * i;
      const float f = Tf[n], bm = Tb[(8192 - n) & 8191];
      const float d = n == 0 ? f + bm : f - bm;
      const v2 w = twid2((float)n * (1.0f / 16384.0f));
      X[xaddr(n)] = d * w; }
    __syncthreads();
    fpass_lds<0, false>(X, tid); __syncthreads(); fpass_lds<1, false>(X, tid); __syncthreads(); fpass_lds<2, false>(X, tid); __syncthreads();
    fmid16<1>(X, tid, nullptr, SPEC + (size_t)(o * 2 + 1) * (FN / 2), scl);
    __syncthreads();
  }
  sync_mem();
}

DI void hyena_conv(const PV& p, int l, int c, char* smem, int tid) {
  v2* X = (v2*)smem;
  const v4* SPEC = (const v4*)((float2*)(p.ws + OFF_H) + (size_t)c * 4 * FN);
  v2* zb = (v2*)((float2*)(p.ws + OFF_CA) + (size_t)blockIdx.x * FN);
  v2* ob = (v2*)((float2*)(p.ws + OFF_OB) + (size_t)blockIdx.x * FN);
  const bf16_t* HY = (const bf16_t*)(p.ws + OFF_HY);
  const float* cw = (const float*)p.in[I_CONVW] + (size_t)l * 3 * 768;
  const float* cb = (const float*)p.in[I_CONVB] + (size_t)l * 768;
  bf16_t* HYO = (bf16_t*)(p.ws + OFF_HYO);
#pragma unroll 1
  for (int pr = 0; pr < 2; ++pr) {
    const int b0 = 2 * pr, b1 = 2 * pr + 1;
    { const bf16_t* r0 = HY + ((size_t)b0 * 768 + c) * S; const bf16_t* r1 = HY + ((size_t)b1 * 768 + c) * S;
      const float w0 = cw[c], w1 = cw[768 + c], w2 = cw[1536 + c], bb = cb[c];
      int tq = tid; asm volatile("" : "+v"(tq));
#pragma unroll 16
      for (int i = 0; i < 32; ++i) { const int n = tq + 256 * i; zb[n] = mk2(conv3(r0, n, w0, w1, w2, bb), conv3(r1, n, w0, w1, w2, bb)); } }
#pragma unroll 1
    for (int o = 0; o < 2; ++o) {
      const v4* Ge = SPEC + (size_t)(o * 2 + 0) * (FN / 2); const v4* Go = SPEC + (size_t)(o * 2 + 1) * (FN / 2);
      const float bias = ((const float*)p.in[I_HBIAS])[(size_t)l * 512 + o * 256 + c];
      fpass<0, false, 1>(X, tid, [&](int n) { return zb[n]; }, [&](int n, v2 raw) { return cmul(raw, twid2((float)n * (1.0f / 16384.0f))); });
      __syncthreads(); fpass_lds<1, false>(X, tid); __syncthreads(); fpass_lds<2, false>(X, tid); __syncthreads();
      fmid16<0>(X, tid, Go, nullptr, 0.f);
      __syncthreads(); fpass_lds<2, true>(X, tid); __syncthreads(); fpass_lds<1, true>(X, tid); __syncthreads();
      fpass<0, true, 1>(X, tid, [&](int n) { return zb[n]; },
                        [&](int n, v2 v, v2 raw) { ob[n] = cmul(v, twidc2((float)n * (1.0f / 16384.0f))) + bias * raw; });
      const int gc = (o + 1) * 256 + c;
      const bf16_t* g0 = HY + ((size_t)b0 * 768 + gc) * S; const bf16_t* g1 = HY + ((size_t)b1 * 768 + gc) * S;
      const float w0 = cw[gc], w1 = cw[768 + gc], w2 = cw[1536 + gc], bb = cb[gc];
      fpass<0, false, 1>(X, tid, [&](int n) { return zb[n]; }, [&](int, v2 raw) { return raw; });
      __syncthreads(); fpass_lds<1, false>(X, tid); __syncthreads(); fpass_lds<2, false>(X, tid); __syncthreads();
      fmid16<0>(X, tid, Ge, nullptr, 0.f);
      __syncthreads(); fpass_lds<2, true>(X, tid); __syncthreads(); fpass_lds<1, true>(X, tid); __syncthreads();
      fpass<0, true, 1>(X, tid, [&](int n) { return ob[n]; },
                        [&](int n, v2 v, v2 raw) { zb[n] = mk2(conv3(g0, n, w0, w1, w2, bb) * (v.x + raw.x), conv3(g1, n, w0, w1, w2, bb) * (v.y + raw.y)); });
    }
    int tq = tid; asm volatile("" : "+v"(tq));
#pragma unroll 8
    for (int i = 0; i < 32; ++i) { const int n = tq + 256 * i; const v2 zz = zb[n];
      HYO[((size_t)b0 * 256 + c) * S + n] = f2bf(zz.x); HYO[((size_t)b1 * 256 + c) * S + n] = f2bf(zz.y); }
  }
  __syncthreads();
}

DI void hyena_item(const PV& p, int l, int c, char* smem, int tid) {
  hyena_spectra(p, l, c, smem, tid);
  asm volatile("" : "+v"(tid), "+s"(c), "+s"(l));
  hyena_conv(p, l, c, smem, tid);
}

constexpr int Q_HY = 32, Q_DIFF = 128, Q_MLA = 128, Q_SWA = 128, Q_LEN = Q_HY + Q_DIFF + Q_MLA + Q_SWA;

DI void phase_l2(const PV& p, int l, char* smem, int wv, int qoff = 0) {
  unsigned* qh = (unsigned*)(p.ws + OFF_CTRL) + CT_QHEAD + l * 8 * 64 + qoff;
  const bool hyena_first = blockIdx.x >= (gridDim.x >> 1);
#pragma unroll 1
  for (int pass = 0; pass < 2; ++pass) {
    if ((pass == 0) == hyena_first) {
      xcd_queue_run(qh + 5, smem, wv, [](int) { return Q_HY; }, [&](int x, int idx, int t) { hyena_item(p, l, x * 32 + idx, smem, t); });
    } else {
      xcd_queue_run(qh, smem, wv, [](int) { return Q_DIFF + Q_MLA + Q_SWA; }, [&](int x, int idx, int t) {
        if (idx < Q_MLA) mla_item(p, x * 2 + (idx >> 6), idx & 63, smem, t);
        else if (idx < Q_DIFF + Q_MLA) { const int j = idx - Q_MLA; diff_item(p, l, x * 2 + (j >> 6), j & 63, smem, t); }
        else { const int j = idx - Q_DIFF - Q_MLA; swa_item(p, l, x * 2 + (j >> 6), j & 63, smem, t); }
      });
    }
  }
}

DI void phase_l3a(const PV& p, int l, char* smem, int wv) {
  const bf16_t* MIX = (const bf16_t*)(p.ws + OFF_MIX);
  const bf16_t* W = (const bf16_t*)(p.ws + OFF_WOUT) + (size_t)l * 1024 * 1024;
  const float* mod = (const float*)(p.ws + OFF_MOD);
  bf16_t* XB = (bf16_t*)p.out;
  xcd_queue_run((unsigned*)(p.ws + OFF_CTRL) + CT_QHEAD + l * 8 * 64 + 2, smem, wv, [](int) { return 256; }, [&](int x, int idx, int tid) {
    const int mg = idx >> 6, rem = idx & 63; const int nt = rem >> 3, mt = x * 32 + mg * 8 + (rem & 7); const int m0 = mt * 128; const int b = m0 >> 13;
    const float* g1 = mod + (size_t)(l * NB + b) * 6144 + 2 * 1024;
    const bf16_t* A = MIX + (size_t)m0 * 1024;
    gemm_tile_l3a(A, (const bf16_t*)(p.ws + OFF_HYO) + (size_t)b * 256 * S + (m0 & 8191), W + (size_t)nt * 128 * 1024, smem, tid,
      [&](f32x16 (&acc)[2][2], int wm, int wn, int r, int h) {
        const bool odd = r & 1;
        unsigned xo[2][2][8];
#pragma unroll
        for (int ni = 0; ni < 2; ++ni)
#pragma unroll
          for (int mi = 0; mi < 2; ++mi) { const int col = nt * 128 + wn * 64 + ni * 32 + r;
            const bf16_t* xc = XB + (size_t)(m0 + wm * 64 + mi * 32 + 4 * h + (odd ? 1 : 0)) * 2048 + (col & ~1);
#pragma unroll
            for (int pq = 0; pq < 8; ++pq) xo[ni][mi][pq] = *(const unsigned*)(xc + (size_t)((2 * pq & 3) + 8 * (pq >> 1)) * 2048); }
#pragma unroll
        for (int ni = 0; ni < 2; ++ni) { const int col = nt * 128 + wn * 64 + ni * 32 + r; const float gv = g1[col];
#pragma unroll
          for (int mi = 0; mi < 2; ++mi) { bf16_t* xc = XB + (size_t)(m0 + wm * 64 + mi * 32 + 4 * h + (odd ? 1 : 0)) * 2048 + (col & ~1);
            float mine[8], theirs[8];
#pragma unroll
            for (int pq = 0; pq < 8; ++pq) { const float a0 = gv * acc[mi][ni][2 * pq], a1 = gv * acc[mi][ni][2 * pq + 1];
              const float send = odd ? a0 : a1; mine[pq] = odd ? a1 : a0;
              theirs[pq] = __builtin_bit_cast(float, __builtin_amdgcn_mov_dpp(__builtin_bit_cast(int, send), 0xB1, 0xF, 0xF, true)); }
#pragma unroll
            for (int pq = 0; pq < 8; ++pq) { const float lo = lo_bf(xo[ni][mi][pq]) + (odd ? theirs[pq] : mine[pq]), hi = hi_bf(xo[ni][mi][pq]) + (odd ? mine[pq] : theirs[pq]);
              *(unsigned*)(xc + (size_t)((2 * pq & 3) + 8 * (pq >> 1)) * 2048) = pack2(lo, hi); }
          }
        }
      });
  });
}

DI void phase_l3b(const PV& p, int l, char* smem, int tid) {
  const bf16_t* WR = (const bf16_t*)(p.ws + OFF_WR) + (size_t)l * 128 * 1024;
  const float* mod = (const float*)(p.ws + OFF_MOD);
  const bf16_t* XB = (const bf16_t*)p.out;
  bf16_t* H = (bf16_t*)(p.ws + OFF_H);
  unsigned* cnt = (unsigned*)(p.ws + OFF_CTRL) + CT_CNT + l * 32;
  int* toke = (int*)(p.ws + OFF_TOKE); int* tokp = (int*)(p.ws + OFF_TOKP);
  int* ltok = (int*)(p.ws + OFF_LTOK); float* lgate = (float*)(p.ws + OFF_LGATE);
  float* logit = (float*)(smem + 55296);
  int* hist = (int*)(smem + 55296 + 64 * 40 * 4);
  int* gbase = hist + 32;
  const float* lnw = (const float*)p.in[I_LN2] + l * 1024;
  for (int mt = blockIdx.x; mt < 512; mt += gridDim.x) {
    const int m0 = mt * 64; const int b = m0 >> 13;
    asm volatile("" : "+v"(tid));
    const int lane = tid & 63, wid = tid >> 6;
    const float* sh2 = mod + (size_t)(l * NB + b) * 6144 + 3 * 1024; const float* sc2 = sh2 + 1024;
#pragma unroll 1
    for (int rr = 0; rr < 16; rr += 4) {
      f32x4 xv[4][4]; float ss[4];
#pragma unroll
      for (int q = 0; q < 4; ++q) { const bf16_t* src = XB + (size_t)(m0 + wid * 16 + rr + q) * 2048 + lane * 4;
#pragma unroll
        for (int i = 0; i < 4; ++i) { const u32x2 xb = *(const u32x2*)(src + 256 * i); xv[q][i].x = lo_bf(xb.x); xv[q][i].y = hi_bf(xb.x); xv[q][i].z = lo_bf(xb.y); xv[q][i].w = hi_bf(xb.y); } }
#pragma unroll
      for (int q = 0; q < 4; ++q) { float a = 0.f;
#pragma unroll
        for (int i = 0; i < 4; ++i) a += xv[q][i].x * xv[q][i].x + xv[q][i].y * xv[q][i].y + xv[q][i].z * xv[q][i].z + xv[q][i].w * xv[q][i].w;
        ss[q] = wave_sum(a, lane); }
#pragma unroll
      for (int q = 0; q < 4; ++q) { const float rstd = rsqrtf(ss[q] * (1.0f / 1024.0f) + EPS); const int row = m0 + wid * 16 + rr + q;
#pragma unroll
        for (int i = 0; i < 4; ++i) { const int c = lane * 4 + 256 * i;
          const f32x4 g = *(const f32x4*)(lnw + c), s1 = *(const f32x4*)(sc2 + c), s0 = *(const f32x4*)(sh2 + c);
          u32x2 o; o.x = pack2(xv[q][i].x * rstd * g.x * (1.f + s1.x) + s0.x, xv[q][i].y * rstd * g.y * (1.f + s1.y) + s0.y);
          o.y = pack2(xv[q][i].z * rstd * g.z * (1.f + s1.z) + s0.z, xv[q][i].w * rstd * g.w * (1.f + s1.w) + s0.w);
          *(u32x2*)(H + (size_t)row * 1024 + c) = o; } }
    }
    if (tid < 32) hist[tid] = 0;
    sync_mem();
    const bf16_t* A2 = H + (size_t)m0 * 1024;
    gemm_tile<64, true>([&](int row) { return A2 + (size_t)row * 1024; }, WR, 1024, 1024, smem, tid,
      [&](f32x16 (&acc)[1][2], int wm, int wn, int r, int h) {
        if (wn == 0) {
#pragma unroll
          for (int ni = 0; ni < 2; ++ni)
#pragma unroll
            for (int i = 0; i < 16; ++i) { const int col = ni * 32 + crow(i, h); if (col < 36) logit[(wm * 32 + r) * 40 + col] = acc[0][ni][i]; }
        }
      });
    __syncthreads();
    int e0 = 0, e1 = 0, r0 = 0, r1 = 0; float gt0 = 0.f, gt1 = 0.f;
    if (tid < 64) {
      const float* lg = logit + tid * 40;
      const float* rgb = (const float*)p.in[I_RGB] + l * 4; const float* reb = (const float*)p.in[I_REB] + l * 32;
      float gl[4]; int gs = 0; float gm;
#pragma unroll
      for (int j = 0; j < 4; ++j) gl[j] = lg[j] + rgb[j];
      gm = gl[0];
#pragma unroll
      for (int j = 1; j < 4; ++j) if (gl[j] > gm) { gm = gl[j]; gs = j; }
      float den = 0.f;
#pragma unroll
      for (int j = 0; j < 4; ++j) den += expf(gl[j] - gm);
      const float pg = 1.0f / den;
      float v0 = -INFINITY, v1 = -INFINITY; int i0 = 0, i1 = 0;
      for (int j = 0; j < 8; ++j) { const float v = lg[4 + gs * 8 + j] + reb[gs * 8 + j];
        if (v > v0) { v1 = v0; i1 = i0; v0 = v; i0 = j; } else if (v > v1) { v1 = v; i1 = j; } }
      const float w0 = 1.0f / (1.0f + expf(v1 - v0));
      e0 = gs * 8 + i0; e1 = gs * 8 + i1; gt0 = pg * w0; gt1 = pg * (1.0f - w0);
      r0 = atomicAdd(&hist[e0], 1); r1 = atomicAdd(&hist[e1], 1);
    }
    __syncthreads();
    if (tid < 32) { const int hc = hist[tid]; gbase[tid] = hc > 0 ? (int)atomicAdd(&cnt[tid], (unsigned)hc) : 0; }
    __syncthreads();
    if (tid < 64) {
      const int tok = m0 + tid; const int p0 = gbase[e0] + r0, p1 = gbase[e1] + r1;
      toke[tok * 2] = e0; toke[tok * 2 + 1] = e1; tokp[tok * 2] = p0; tokp[tok * 2 + 1] = p1;
      ltok[(size_t)e0 * LCAP + p0] = tok; ltok[(size_t)e1 * LCAP + p1] = tok; lgate[(size_t)e0 * LCAP + p0] = gt0; lgate[(size_t)e1 * LCAP + p1] = gt1;
    }
    __syncthreads();
  }
}

DI void moe_rb_table(const unsigned* cnt, int* rbs  , int tid) {
  if (tid == 0) { int acc = 0; for (int e = 0; e < 32; ++e) { rbs[e] = acc; acc += ((int)cnt[e] + 127) >> 7; } rbs[32] = acc; }
  __syncthreads();
}

DI void phase_m2(const PV& p, int l, char* smem, int wv) {
  int* rbs = (int*)(smem + LDS_BYTES - 256);
  const unsigned* cnt = (const unsigned*)(p.ws + OFF_CTRL) + CT_CNT + l * 32;
  moe_rb_table(cnt, rbs, my_tid(wv));
  const bf16_t* H = (const bf16_t*)(p.ws + OFF_H);
  const int* ltok = (const int*)(p.ws + OFF_LTOK);
  bf16_t* ACT = (bf16_t*)(p.ws + OFF_ACT);
  auto nrb = [&](int e) { return rbs[e + 1] - rbs[e]; };
  xcd_queue_run((unsigned*)(p.ws + OFF_CTRL) + CT_QHEAD + l * 8 * 64 + 3, smem, wv,
    [&](int x) { return (nrb(x) + nrb(x + 8) + nrb(x + 16) + nrb(x + 24)) * 4; }, [&](int x, int idx, int tid) {
    int e = x, q = idx >> 2; const int nt = idx & 3;
    while (q >= nrb(e)) { q -= nrb(e); e += 8; }
    const int rb = q, rbg = rbs[e] + rb; const int ce = (int)cnt[e];
    const size_t slot0 = (size_t)rbg * 128;
    const int* lt = ltok + (size_t)e * LCAP + rb * 128; const int nvalid = ce - rb * 128;
    const bf16_t* Bt = (const bf16_t*)(p.ws + OFF_WGU) + ((size_t)(l * 32 + e) * 512 + nt * 128) * 1024;
    gemm_tile<128, true>([&](int row) { const int tok = row < nvalid ? lt[row] : 0; return H + (size_t)tok * 1024; }, Bt, 1024, 1024, smem, tid,
      [&](f32x16 (&acc)[2][2], int wm, int wn, int r, int h) {
#pragma unroll
        for (int mi = 0; mi < 2; ++mi) { bf16_t* dst = ACT + (slot0 + wm * 64 + mi * 32 + r) * 256 + nt * 64 + wn * 32;
#pragma unroll
          for (int g = 0; g < 4; ++g) { float o[4];
#pragma unroll
            for (int k = 0; k < 4; ++k) o[k] = silu(acc[mi][0][4 * g + k]) * acc[mi][1][4 * g + k];
            store4_bf(dst + 8 * g + 4 * h, o[0], o[1], o[2], o[3]); }
        }
      });
  });
}

DI void phase_m3(const PV& p, int l, char* smem, int wv) {
  int* rbs = (int*)(smem + LDS_BYTES - 256);
  const unsigned* cnt = (const unsigned*)(p.ws + OFF_CTRL) + CT_CNT + l * 32;
  moe_rb_table(cnt, rbs, my_tid(wv));
  const bf16_t* ACT = (const bf16_t*)(p.ws + OFF_ACT);
  const float* lgate = (const float*)(p.ws + OFF_LGATE);
  bf16_t* Y = (bf16_t*)(p.ws + OFF_Y);
  auto nrb = [&](int e) { return rbs[e + 1] - rbs[e]; };
  xcd_queue_run((unsigned*)(p.ws + OFF_CTRL) + CT_QHEAD + l * 8 * 64 + 4, smem, wv,
    [&](int x) { return (nrb(x) + nrb(x + 8) + nrb(x + 16) + nrb(x + 24)) * 8; }, [&](int x, int idx, int tid) {
    int e = x, q = idx >> 3; const int nt = idx & 7;
    while (q >= nrb(e)) { q -= nrb(e); e += 8; }
    const int rb = q, rbg = rbs[e] + rb; const int ce = (int)cnt[e];
    const size_t slot0 = (size_t)rbg * 128;
    const float* lg = lgate + (size_t)e * LCAP + rb * 128; const int nvalid = ce - rb * 128;
    const bf16_t* A = ACT + slot0 * 256;
    const bf16_t* Bt = (const bf16_t*)(p.ws + OFF_WD) + ((size_t)(l * 32 + e) * 1024 + nt * 128) * 256;
    float gtv[2];
    { const int rw = ((tid >> 7) & 1) * 64 + (tid & 31);
#pragma unroll
      for (int mi = 0; mi < 2; ++mi) gtv[mi] = (rw + mi * 32) < nvalid ? lg[rw + mi * 32] : 0.f; }
    gemm_tile<128, true>([&](int row) { return A + (size_t)row * 256; }, Bt, 256, 256, smem, tid,
      [&](f32x16 (&acc)[2][2], int wm, int wn, int r, int h) {
        bf16_t* Tl = (bf16_t*)smem;
#pragma unroll
        for (int mi = 0; mi < 2; ++mi) { const int row = wm * 64 + mi * 32 + r; const float gt = gtv[mi];
#pragma unroll
          for (int ni = 0; ni < 2; ++ni)
#pragma unroll
            for (int g = 0; g < 4; ++g) store4_bf(Tl + row * 136 + wn * 64 + ni * 32 + 8 * g + 4 * h, acc[mi][ni][4 * g] * gt, acc[mi][ni][4 * g + 1] * gt, acc[mi][ni][4 * g + 2] * gt, acc[mi][ni][4 * g + 3] * gt);
        }
        __syncthreads();
#pragma unroll
        for (int i = 0; i < 8; ++i) { const int c = tid + 256 * i, row = c >> 4, ch = c & 15;
          *(u32x4*)(Y + (slot0 + row) * 1024 + nt * 128 + ch * 8) = *(const u32x4*)(Tl + row * 136 + ch * 8); }
        __syncthreads();
      });
  });
}

#define XB_TMO      128
#define XB_XCNT(j)  (256  + 64 * (j))
#define XB_XSUB(j)  (1280 + 64 * (j))
#define XB_XGEN(j)  (2304 + 64 * (j))
#define XB_TOP      3328
#define XB_TOPGEN   3392
#define XCD_BAR_WORDS 3456
#define XB_SPIN_CAP (1u << 18)
#define LAS __attribute__((address_space(3)))

__device__ __forceinline__ unsigned xb_ld(unsigned* p)              { return __hip_atomic_load(p, __ATOMIC_RELAXED, __HIP_MEMORY_SCOPE_AGENT); }
__device__ __forceinline__ unsigned xb_add(unsigned* p, unsigned v) { return __hip_atomic_fetch_add(p, v, __ATOMIC_RELAXED, __HIP_MEMORY_SCOPE_AGENT); }
__device__ __forceinline__ unsigned xb_xcc_id() { return (unsigned)__builtin_amdgcn_s_getreg((3 << 11) | 20) & 0xFu; }
#define XB_SPIN(cond, bar) do { unsigned _sp = 0; while (cond) { __builtin_amdgcn_s_sleep(1); \
    if ((++_sp & 255u) == 0u) { if (xb_ld(&(bar)[XB_TMO])) break; if (_sp > XB_SPIN_CAP) { atomicAdd(&(bar)[XB_TMO], 1u); break; } } } } while (0)

struct XcdBarrier {
    unsigned* bar; unsigned x;
    volatile LAS unsigned* st;
};
__device__ __forceinline__ XcdBarrier xcd_barrier_post(unsigned* bar, volatile LAS unsigned* st) {
    XcdBarrier b; b.bar = bar; b.x = xb_xcc_id(); b.st = st;
    if (threadIdx.x == 0) (void)xb_add(&bar[XB_XCNT(b.x)], 1u);
    return b;
}
__device__ __forceinline__ void xcd_barrier_complete(unsigned* bar, unsigned x, unsigned& nloc, unsigned& nx) {
    const unsigned G = gridDim.x * gridDim.y * gridDim.z;
    unsigned sum, cnt, mine, sp = 0u;
    for (;;) {
        sum = 0u; cnt = 0u; mine = 0u;
#pragma unroll
        for (unsigned j = 0; j < 16; ++j) { const unsigned c = xb_ld(&bar[XB_XCNT(j)]); sum += c; cnt += (c > 0u) ? 1u : 0u; mine = (j == x) ? c : mine; }
        if (sum == G) break;
        __builtin_amdgcn_s_sleep(1);
        if ((++sp & 255u) == 0u) { if (xb_ld(&bar[XB_TMO])) break; if (sp > XB_SPIN_CAP) { atomicAdd(&bar[XB_TMO], 1u); break; } }
    }
    nloc = mine > 0u ? mine : 1u; nx = cnt > 0u ? cnt : 1u;
}
__device__ __forceinline__ void xcd_barrier(const XcdBarrier& b, const bool is_t0  ) {
    asm volatile("s_waitcnt vmcnt(0)" ::: "memory");
    __syncthreads();
    if (is_t0) {
        unsigned* bar = b.bar;
        __builtin_amdgcn_s_waitcnt(0);
        unsigned nloc = b.st[0], nx = b.st[1];
        if (nloc == 0u) { xcd_barrier_complete(bar, b.x, nloc, nx); b.st[0] = nloc; b.st[1] = nx; }
        const unsigned old = xb_add(&bar[XB_XSUB(b.x)], 1u);
        const unsigned gen = old / nloc;
        if (old + 1u == (gen + 1u) * nloc) {
            __builtin_amdgcn_fence(__ATOMIC_RELEASE, "agent");
            asm volatile("s_waitcnt vmcnt(0)" ::: "memory");
            const unsigned og = xb_add(&bar[XB_TOP], 1u);
            const unsigned tg = og / nx;
            if (og + 1u == (tg + 1u) * nx) xb_add(&bar[XB_TOPGEN], 1u);
            else XB_SPIN(xb_ld(&bar[XB_TOPGEN]) == tg, bar);
            __builtin_amdgcn_fence(__ATOMIC_ACQUIRE, "agent");
            xb_add(&bar[XB_XGEN(b.x)], 1u);
            asm volatile("s_waitcnt vmcnt(0)" ::: "memory");
        } else {
            XB_SPIN(xb_ld(&bar[XB_XGEN(b.x)]) == gen, bar);
            __builtin_amdgcn_fence(__ATOMIC_ACQUIRE, "agent");
            asm volatile("s_waitcnt vmcnt(0)" ::: "memory");
        }
    }
    __syncthreads();
}

#ifndef DUP_PHASE
#define DUP_PHASE 0
#endif
constexpr int CT_BAR = 8192;
#define MYTID my_tid(wv)
#define PHASE(call) { const PV p = mkpv(); int t = MYTID; asm volatile("" : "+v"(t)); call; }
DI void gbar(XcdBarrier b, int t) { asm volatile("" : "+s"(b.bar), "+s"(b.x)); xcd_barrier(b, t == 0); }

__global__ void __launch_bounds__(NTHREADS, 2) k_mega(Params pk) {
  extern __shared__ __attribute__((aligned(16))) char smem[];
  const int wv = __builtin_amdgcn_readfirstlane((int)(threadIdx.x >> 6));
  volatile LAS unsigned* xbw = (volatile LAS unsigned*)(smem + LDS_BYTES - 64);
  if (threadIdx.x == 0) { xbw[0] = 0u; xbw[1] = 0u; xbw[2] = 0u; xbw[3] = 0u; }
  __syncthreads();
  XcdBarrier bar = xcd_barrier_post((unsigned*)(pk.ws + OFF_CTRL) + CT_BAR, xbw);
  PHASE(phase_pa(p, smem, t))
  gbar(bar, MYTID);
#if DUP_PHASE == 1
  PHASE(phase_pa(p, smem, t))
  gbar(bar, MYTID);
#endif
#pragma unroll 1
  for (int l = 0; l < NL; ++l) {
    PHASE(phase_l0<false>(p, l, smem, t))
    gbar(bar, MYTID);
    { const PV p = mkpv(); phase_l1(p, l, smem, wv); }
    gbar(bar, MYTID);
#if DUP_PHASE == 2
    { const PV p = mkpv(); phase_l1(p, l, smem, wv); }
    gbar(bar, MYTID);
#endif
    PHASE(phase_l1b(p, l, smem, t))
    gbar(bar, MYTID);
#if DUP_PHASE == 3
    PHASE(phase_l1b(p, l, smem, t))
    gbar(bar, MYTID);
#endif
    { const PV p = mkpv(); phase_l2(p, l, smem, wv); }
    gbar(bar, MYTID);
#if DUP_PHASE == 4
    { const PV p = mkpv(); phase_l2(p, l, smem, wv, 32); }
    gbar(bar, MYTID);
#endif
    { const PV p = mkpv(); phase_l3a(p, l, smem, wv); }
    gbar(bar, MYTID);
    PHASE(phase_l3b(p, l, smem, t))
    gbar(bar, MYTID);
    { const PV p = mkpv(); phase_m2(p, l, smem, wv); }
    gbar(bar, MYTID);
#if DUP_PHASE == 5
    { const PV p = mkpv(); phase_m2(p, l, smem, wv); }
    gbar(bar, MYTID);
#endif
    { const PV p = mkpv(); phase_m3(p, l, smem, wv); }
    gbar(bar, MYTID);
#if DUP_PHASE == 6
    { const PV p = mkpv(); phase_m3(p, l, smem, wv); }
    gbar(bar, MYTID);
#endif
  }
  PHASE(phase_l0<true>(p, NL, smem, t))
}

extern "C" void kernel_launch(void* const* d_in, const int* in_sizes, int n_in, void* d_out, int out_size, void* d_ws, size_t ws_size, hipStream_t stream) {
  (void)in_sizes; (void)out_size;
  if (n_in < N_IN || ws_size < WS_NEEDED) { fprintf(stderr, "kernel_launch: unexpected inputs / workspace (%d, %zu < %zu)\n", n_in, ws_size, (size_t)WS_NEEDED); return; }
  static int grid = 0;
  if (!grid) {
    int dev = 0, cus = 0, per_cu = 0;
    (void)hipGetDevice(&dev);
    (void)hipDeviceGetAttribute(&cus, hipDeviceAttributeMultiprocessorCount, dev);
    (void)hipFuncSetAttribute((const void*)k_mega, hipFuncAttributeMaxDynamicSharedMemorySize, LDS_BYTES);
    (void)hipOccupancyMaxActiveBlocksPerMultiprocessor(&per_cu, k_mega, NTHREADS, LDS_BYTES);
    if (cus <= 0) cus = 256;
    if (per_cu < 1) per_cu = 1;
    grid = cus * (per_cu < 2 ? per_cu : 2);
    if (grid > GRID) grid = GRID;
  }
  Params p{};
  for (int i = 0; i < N_IN; ++i) p.in[i] = d_in[i];
  p.out = (float*)d_out; p.ws = (char*)d_ws;
  (void)hipMemsetAsync((char*)d_ws + OFF_CTRL, 0, 65536, stream);
  hipLaunchKernelGGL(k_mega, dim3(grid), dim3(NTHREADS), LDS_BYTES, stream, p);
}
```

```cpp
#include <hip/hip_runtime.h>
#include <stdint.h>
#include <stdio.h>
#include <type_traits>

#define DI __device__ __forceinline__
typedef unsigned short bf16_t;
typedef short bf16x8 __attribute__((ext_vector_type(8)));
typedef float f32x16 __attribute__((ext_vector_type(16)));
typedef float f32x4 __attribute__((ext_vector_type(4)));
typedef float f32x2 __attribute__((ext_vector_type(2)));
typedef unsigned u32x4 __attribute__((ext_vector_type(4)));
typedef unsigned u32x2 __attribute__((ext_vector_type(2)));
typedef __bf16 bf2_t __attribute__((ext_vector_type(2)));

#define MFMA32(a, b, c) __builtin_amdgcn_mfma_f32_32x32x16_bf16((a), (b), (c), 0, 0, 0)
#define COSREV(f) __builtin_amdgcn_cosf(f)
#define SINREV(f) __builtin_amdgcn_sinf(f)

constexpr int NB = 4, S = 8192, T = NB * S, D = 1024, NL = 4;
constexpr int INC = 2464, NPAD = 2560;
constexpr float EPS = 1e-6f;
constexpr float LOG2E = 1.4426950408889634f;
constexpr int NTHREADS = 256;
constexpr int GRID = 512;
constexpr int LDS_BYTES = 77824;
constexpr int PSLOTS = 65536 + 32 * 128;
constexpr int LCAP = 32768;

enum { I_X = 0, I_C, I_POS, I_LN1, I_LN2, I_ADAW, I_ADAB, I_WIN, I_QNORM, I_KVNORM, I_WUQ, I_WUKV, I_SINK, I_LAMBDA, I_DNORM,
       I_CONVW, I_CONVB, I_HW1, I_HB1, I_HW2, I_HB2, I_HW3, I_HB3, I_HW4, I_HFREQ, I_HBIAS, I_WOUT, I_RGW, I_RGB, I_REW, I_REB,
       I_MG, I_MU, I_MD, I_FINAL, N_IN };

constexpr size_t al256(size_t x) { return (x + 255) & ~(size_t)255; }
constexpr size_t OFF_CTRL = 0;
constexpr size_t OFF_MOD  = 65536;
constexpr size_t OFF_H3   = OFF_MOD + al256((size_t)NL * NB * 6144 * 4);
constexpr size_t OFF_WIN  = OFF_H3 + (size_t)NL * 8192 * 64 * 4;
constexpr size_t OFF_WOUT = OFF_WIN + (size_t)NL * NPAD * 1024 * 2;
constexpr size_t OFF_WUQ  = OFF_WOUT + (size_t)NL * 1024 * 1024 * 2;
constexpr size_t OFF_WUKV = OFF_WUQ + (size_t)NL * 384 * 256 * 2;
constexpr size_t OFF_WR   = OFF_WUKV + (size_t)NL * 512 * 128 * 2;
constexpr size_t OFF_WGU  = OFF_WR + (size_t)NL * 128 * 1024 * 2;
constexpr size_t OFF_WD   = OFF_WGU + (size_t)NL * 32 * 512 * 1024 * 2;
constexpr size_t OFF_H    = OFF_WD + (size_t)NL * 32 * 1024 * 256 * 2;
constexpr size_t OFF_TOKE = OFF_H + (size_t)T * 1024 * 2;
constexpr size_t OFF_TOKP = OFF_TOKE + (size_t)T * 2 * 4;
constexpr size_t OFF_LTOK = OFF_TOKP + (size_t)T * 2 * 4;
constexpr size_t OFF_LGATE= OFF_LTOK + (size_t)32 * LCAP * 4;
constexpr size_t OFF_OB   = OFF_LGATE + (size_t)32 * LCAP * 4;
constexpr size_t OFF_R1   = OFF_OB + (size_t)512 * 8192 * 8;
constexpr size_t OFF_CA   = OFF_R1;
constexpr size_t OFF_QM   = OFF_CA + (size_t)T * 512 * 2;
constexpr size_t OFF_KM   = OFF_QM + (size_t)16 * S * 96 * 2;
constexpr size_t OFF_VMT  = OFF_KM + (size_t)16 * S * 96 * 2;
constexpr size_t OFF_QS   = OFF_VMT + (size_t)16 * 64 * S * 2;
constexpr size_t OFF_KS   = OFF_QS + (size_t)16 * S * 64 * 2;
constexpr size_t OFF_VST  = OFF_KS + (size_t)8 * S * 64 * 2;
constexpr size_t OFF_QD   = OFF_VST + (size_t)8 * 64 * S * 2;
constexpr size_t OFF_KD   = OFF_QD + (size_t)16 * S * 64 * 2;
constexpr size_t OFF_VDT  = OFF_KD + (size_t)16 * S * 64 * 2;
constexpr size_t OFF_HY   = OFF_VDT + (size_t)16 * 64 * S * 2;
constexpr size_t OFF_MIX  = OFF_HY + (size_t)NB * 768 * S * 2;
constexpr size_t OFF_END  = OFF_MIX + (size_t)T * 1024 * 2;
constexpr size_t OFF_Y    = OFF_R1;
constexpr size_t OFF_ACT  = OFF_Y + (size_t)PSLOTS * 1024 * 2;
static_assert(OFF_ACT + (size_t)PSLOTS * 256 * 2 <= OFF_MIX, "MoE buffers must not overlap MIX");
constexpr size_t OFF_HYO  = OFF_END;
constexpr size_t WS_NEEDED = OFF_HYO + (size_t)NB * 256 * S * 2;

constexpr int CT_CNT = 0;
constexpr int CT_QHEAD = 256;

struct Params {
  const void* in[N_IN];
  float* out;
  char* ws;
};
typedef const __attribute__((address_space(4))) char* kptr_t;
typedef __attribute__((address_space(1))) char* gptr_t;
typedef gptr_t const __attribute__((address_space(4)))* kq_t;
struct KIn { kptr_t ka; DI const void* operator[](int i) const { return (const void*)(*(kq_t)(ka + 8 * i)); } };
struct PV { KIn in; float* out; char* ws; };
DI PV mkpv() {
  kptr_t ka = (kptr_t)__builtin_amdgcn_kernarg_segment_ptr();
  asm volatile("" : "+s"(ka));
  PV v; v.in.ka = ka; v.out = (float*)(*(kq_t)(ka + 8 * N_IN)); v.ws = (char*)(*(kq_t)(ka + 8 * (N_IN + 1)));
  return v;
}

DI float bf2f(bf16_t v) { return __uint_as_float(((unsigned)v) << 16); }
DI unsigned pack2(float a, float b) { bf2_t v; v.x = (__bf16)a; v.y = (__bf16)b; return __builtin_bit_cast(unsigned, v); }
DI bf16_t f2bf(float a) { return __builtin_bit_cast(bf16_t, (__bf16)a); }
DI float lo_bf(unsigned u) { return __uint_as_float(u << 16); }
DI float hi_bf(unsigned u) { return __uint_as_float(u & 0xffff0000u); }
DI int crow(int i, int h) { return (i & 3) + 8 * (i >> 2) + 4 * h; }
DI float shx(float v, int m, int lane) { return __builtin_bit_cast(float, __builtin_amdgcn_ds_bpermute((lane ^ m) << 2, __builtin_bit_cast(int, v))); }
DI float wave_sum(float v, int lane) {
  v += shx(v, 32, lane); v += shx(v, 16, lane); v += shx(v, 8, lane); v += shx(v, 4, lane); v += shx(v, 2, lane); v += shx(v, 1, lane);
  return v;
}
DI void sync_mem() { asm volatile("s_waitcnt vmcnt(0)" ::: "memory"); __syncthreads(); }
DI int my_tid(int wv) {
  int lane; asm volatile("v_mbcnt_lo_u32_b32 %0, -1, 0\n\tv_mbcnt_hi_u32_b32 %0, -1, %0" : "=v"(lane)); asm volatile("" : "+s"(wv)); return (wv << 6) | lane; }
DI float silu(float x) { return x / (1.0f + __expf(-x)); }
DI float fast_sin(float x) { return __builtin_amdgcn_sinf(__builtin_amdgcn_fractf(x * 0.15915494309189535f)); }
DI float fast_cos(float x) { return __builtin_amdgcn_cosf(__builtin_amdgcn_fractf(x * 0.15915494309189535f)); }
DI float rope_freq(int i, int half) { return expf((-9.210340371976184f * (float)i) / (float)half); }
DI void rope_sincos(float ps, int i, int half, float& sn, float& cs) {
  const float fr = __builtin_amdgcn_exp2f((-13.287712379549449f * (float)i) / (float)half) * 0.15915494309189535f;
  const float pr = ps * fr, er = __builtin_fmaf(ps, fr, -pr);
  const float rev = __builtin_amdgcn_fractf(pr) + er;
  sn = __builtin_amdgcn_sinf(rev); cs = __builtin_amdgcn_cosf(rev);
}

constexpr int LP = 72;

template <int BM, bool SWAP, class RowPtr, class Epi>
DI void gemm_tile(RowPtr rowptr, const bf16_t* __restrict__ Bt, int ldb, int K, char* smem, int tid, Epi epi) {
  constexpr int MI = BM / 64;
  constexpr int ACH = BM / 32;
  bf16_t* As = (bf16_t*)smem;
  bf16_t* Bs = As + 2 * BM * LP;
  const int lane = tid & 63, wid = tid >> 6, wm = wid >> 1, wn = wid & 1, r = lane & 31, h = lane >> 5;
  const int cr = tid >> 3, kc = tid & 7;
  const bf16_t* ap[ACH];
#pragma unroll
  for (int i = 0; i < ACH; ++i) ap[i] = rowptr(cr + 32 * i) + kc * 8;
  const bf16_t* bp = Bt + (size_t)cr * ldb + kc * 8;
  u32x4 ra0[ACH], rb0[4], ra1[ACH], rb1[4];
  f32x16 acc[MI][2];
#pragma unroll
  for (int mi = 0; mi < MI; ++mi)
#pragma unroll
    for (int ni = 0; ni < 2; ++ni)
#pragma unroll
      for (int i = 0; i < 16; ++i) acc[mi][ni][i] = 0.f;
  const int KT = K >> 6;
  auto gload = [&](u32x4 (&ra)[ACH], u32x4 (&rb)[4], int k0) {
#pragma unroll
    for (int i = 0; i < ACH; ++i) ra[i] = *(const u32x4*)(ap[i] + k0);
#pragma unroll
    for (int i = 0; i < 4; ++i) rb[i] = *(const u32x4*)(bp + (size_t)(32 * i) * ldb + k0);
  };
  auto lstore = [&](const u32x4 (&ra)[ACH], const u32x4 (&rb)[4], int buf) {
#pragma unroll
    for (int i = 0; i < ACH; ++i) *(u32x4*)(As + (buf * BM + cr + 32 * i) * LP + kc * 8) = ra[i];
#pragma unroll
    for (int i = 0; i < 4; ++i) *(u32x4*)(Bs + (buf * 128 + cr + 32 * i) * LP + kc * 8) = rb[i];
  };
  auto compute = [&](int buf) {
    const bf16_t* Ab = As + (buf * BM + wm * (BM / 2) + r) * LP + 8 * h;
    const bf16_t* Bb = Bs + (buf * 128 + wn * 64 + r) * LP + 8 * h;
    bf16x8 af[3][MI], bfr[3][2];
#pragma unroll
    for (int k0 = 0; k0 < 2; ++k0) {
#pragma unroll
      for (int mi = 0; mi < MI; ++mi) af[k0][mi] = *(const bf16x8*)(Ab + mi * 32 * LP + k0 * 16);
#pragma unroll
      for (int ni = 0; ni < 2; ++ni) bfr[k0][ni] = *(const bf16x8*)(Bb + ni * 32 * LP + k0 * 16);
    }
    __builtin_amdgcn_sched_group_barrier(0x100, 2 * (MI + 2), 0);
#pragma unroll
    for (int ks = 0; ks < 4; ++ks) {
      if (ks < 2) {
#pragma unroll
        for (int mi = 0; mi < MI; ++mi) af[(ks + 2) % 3][mi] = *(const bf16x8*)(Ab + mi * 32 * LP + (ks + 2) * 16);
#pragma unroll
        for (int ni = 0; ni < 2; ++ni) bfr[(ks + 2) % 3][ni] = *(const bf16x8*)(Bb + ni * 32 * LP + (ks + 2) * 16);
      }
#pragma unroll
      for (int mi = 0; mi < MI; ++mi)
#pragma unroll
        for (int ni = 0; ni < 2; ++ni)
          acc[mi][ni] = SWAP ? MFMA32(bfr[ks % 3][ni], af[ks % 3][mi], acc[mi][ni]) : MFMA32(af[ks % 3][mi], bfr[ks % 3][ni], acc[mi][ni]);
      if (ks < 2) __builtin_amdgcn_sched_group_barrier(0x100, MI + 2, 0);
      __builtin_amdgcn_sched_group_barrier(0x008, MI * 2, 0);
      if (ks == 1) __builtin_amdgcn_sched_group_barrier(0x200, ACH + 4, 0);
    }
  };
  gload(ra0, rb0, 0);
  gload(ra1, rb1, 64);
  lstore(ra0, rb0, 0);
  __syncthreads();
  for (int kt = 0; kt < KT; kt += 2) {
    if (kt + 2 < KT) gload(ra0, rb0, (kt + 2) << 6);
    compute(0);
    lstore(ra1, rb1, 1);
    __syncthreads();
    if (kt + 3 < KT) gload(ra1, rb1, (kt + 3) << 6);
    compute(1);
    if (kt + 2 < KT) lstore(ra0, rb0, 0);
    __syncthreads();
  }
  epi(acc, wm, wn, r, h);
}

typedef short v4i16_t __attribute__((ext_vector_type(4)));
DI int troff(int row, int ch) { return 256 * row + 16 * (ch ^ (((row & 3) << 2) | ((row >> 2) & 3))); }
DI bf16x8 tr_frag(const char* base, int o0, int o1) {
  const v4i16_t lo = __builtin_amdgcn_ds_read_tr16_b64_v4i16((__attribute__((address_space(3))) v4i16_t*)(base + o0));
  const v4i16_t hi = __builtin_amdgcn_ds_read_tr16_b64_v4i16((__attribute__((address_space(3))) v4i16_t*)(base + o1));
  bf16x8 r; r[0] = lo[0]; r[1] = lo[1]; r[2] = lo[2]; r[3] = lo[3]; r[4] = hi[0]; r[5] = hi[1]; r[6] = hi[2]; r[7] = hi[3]; return r;
}
template <class Epi>
DI void gemm_tile_l3a(const bf16_t* __restrict__ A, const bf16_t* __restrict__ Hy, const bf16_t* __restrict__ Bt, char* smem, int tid, Epi epi) {
  constexpr int BM = 128, MI = 2, ACH = 4, KT = 16, KS0 = 12, ldb = 1024;
  bf16_t* As = (bf16_t*)smem;
  bf16_t* Bs = As + 2 * BM * LP;
  const int lane = tid & 63, wid = tid >> 6, wm = wid >> 1, wn = wid & 1, r = lane & 31, h = lane >> 5;
  const int cr = tid >> 3, kc = tid & 7;
  const bf16_t* ap[ACH];
#pragma unroll
  for (int i = 0; i < ACH; ++i) ap[i] = A + (size_t)(cr + 32 * i) * 1024 + kc * 8;
  const bf16_t* bp = Bt + (size_t)cr * ldb + kc * 8;
  u32x4 ra0[ACH], rb0[4], ra1[ACH], rb1[4];
  f32x16 acc[MI][2];
#pragma unroll
  for (int mi = 0; mi < MI; ++mi)
#pragma unroll
    for (int ni = 0; ni < 2; ++ni)
#pragma unroll
      for (int i = 0; i < 16; ++i) acc[mi][ni][i] = 0.f;
  auto gload = [&](u32x4 (&ra)[ACH], u32x4 (&rb)[4], const int kt) {
    if (kt < KS0) {
#pragma unroll
      for (int i = 0; i < ACH; ++i) ra[i] = *(const u32x4*)(ap[i] + (kt << 6));
    } else {
#pragma unroll
      for (int i = 0; i < ACH; ++i) { const int pc = tid + 256 * i; ra[i] = *(const u32x4*)(Hy + (size_t)(((kt - KS0) << 6) + (pc >> 4)) * S + (pc & 15) * 8); }
    }
#pragma unroll
    for (int i = 0; i < 4; ++i) rb[i] = *(const u32x4*)(bp + (size_t)(32 * i) * ldb + (kt << 6));
  };
  auto lstore = [&](const u32x4 (&ra)[ACH], const u32x4 (&rb)[4], const int buf, const int kt) {
    if (kt < KS0) {
#pragma unroll
      for (int i = 0; i < ACH; ++i) *(u32x4*)(As + (buf * BM + cr + 32 * i) * LP + kc * 8) = ra[i];
    } else {
#pragma unroll
      for (int i = 0; i < ACH; ++i) { const int pc = tid + 256 * i; *(u32x4*)((char*)(As + buf * BM * LP) + troff(pc >> 4, pc & 15)) = ra[i]; }
    }
#pragma unroll
    for (int i = 0; i < 4; ++i) *(u32x4*)(Bs + (buf * 128 + cr + 32 * i) * LP + kc * 8) = rb[i];
  };
  auto compute = [&](const int buf, const int kt) {
    const bf16_t* Bb = Bs + (buf * 128 + wn * 64 + r) * LP + 8 * h;
    if (kt < KS0) {
      const bf16_t* Ab = As + (buf * BM + wm * (BM / 2) + r) * LP + 8 * h;
      bf16x8 af[3][MI], bfr[3][2];
#pragma unroll
      for (int k0 = 0; k0 < 2; ++k0) {
#pragma unroll
        for (int mi = 0; mi < MI; ++mi) af[k0][mi] = *(const bf16x8*)(Ab + mi * 32 * LP + k0 * 16);
#pragma unroll
        for (int ni = 0; ni < 2; ++ni) bfr[k0][ni] = *(const bf16x8*)(Bb + ni * 32 * LP + k0 * 16);
      }
      __builtin_amdgcn_sched_group_barrier(0x100, 2 * (MI + 2), 0);
#pragma unroll
      for (int ks = 0; ks < 4; ++ks) {
        if (ks < 2) {
#pragma unroll
          for (int mi = 0; mi < MI; ++mi) af[(ks + 2) % 3][mi] = *(const bf16x8*)(Ab + mi * 32 * LP + (ks + 2) * 16);
#pragma unroll
          for (int ni = 0; ni < 2; ++ni) bfr[(ks + 2) % 3][ni] = *(const bf16x8*)(Bb + ni * 32 * LP + (ks + 2) * 16);
        }
#pragma unroll
        for (int mi = 0; mi < MI; ++mi)
#pragma unroll
          for (int ni = 0; ni < 2; ++ni) acc[mi][ni] = MFMA32(af[ks % 3][mi], bfr[ks % 3][ni], acc[mi][ni]);
        if (ks < 2) __builtin_amdgcn_sched_group_barrier(0x100, MI + 2, 0);
        __builtin_amdgcn_sched_group_barrier(0x008, MI * 2, 0);
        if (ks == 1) __builtin_amdgcn_sched_group_barrier(0x200, ACH + 4, 0);
      }
    } else {
      const char* Ab = (const char*)(As + buf * BM * LP);
      const int gl = lane >> 4, q = (lane & 15) >> 2, pp = lane & 3;
#pragma unroll
      for (int ks = 0; ks < 4; ++ks) {
        bf16x8 af[MI], bfr[2];
#pragma unroll
        for (int mi = 0; mi < MI; ++mi) { const int row = ks * 16 + 8 * (gl >> 1) + q, ch = ((wm * 64 + mi * 32 + 16 * (gl & 1)) >> 3) + (pp >> 1);
          af[mi] = tr_frag(Ab, troff(row, ch) + 8 * (pp & 1), troff(row + 4, ch) + 8 * (pp & 1)); }
#pragma unroll
        for (int ni = 0; ni < 2; ++ni) bfr[ni] = *(const bf16x8*)(Bb + ni * 32 * LP + ks * 16);
#pragma unroll
        for (int mi = 0; mi < MI; ++mi)
#pragma unroll
          for (int ni = 0; ni < 2; ++ni) acc[mi][ni] = MFMA32(af[mi], bfr[ni], acc[mi][ni]);
      }
    }
  };
  gload(ra0, rb0, 0);
  gload(ra1, rb1, 1);
  lstore(ra0, rb0, 0, 0);
  __syncthreads();
#pragma unroll
  for (int kt = 0; kt < KT; kt += 2) {
    if (kt + 2 < KT) gload(ra0, rb0, kt + 2);
    compute(0, kt);
    lstore(ra1, rb1, 1, kt + 1);
    __syncthreads();
    if (kt + 3 < KT) gload(ra1, rb1, kt + 3);
    compute(1, kt + 1);
    if (kt + 2 < KT) lstore(ra0, rb0, 0, kt + 2);
    __syncthreads();
  }
  epi(acc, wm, wn, r, h);
}

DI int map_in(int n) {
  if (n < 384) return n;
  if (n < 512) return (n - 384) < 32 ? n : -1;
  if (n < 768) return 416 + (n - 512);
  if (n < 896) return 672 + (n - 768);
  if (n < 1024) return 800 + (n - 896);
  if (n < 1536) {
    const int isk = n >= 1280; const int loc = n - (isk ? 1280 : 1024);
    const int head = loc >> 6, within = loc & 63, nb = within >> 5, c = within & 31, which = c >> 4, idx = 16 * nb + (c & 15);
    return (isk ? 1184 : 928) + head * 64 + which * 32 + idx;
  }
  if (n < 1792) return 1440 + (n - 1536);
  return 1696 + (n - 1792);
}
DI int map_uq(int n) {
  if (n < 256) return (n >> 6) * 96 + (n & 63);
  const int loc = n - 256, wn = loc >> 6, within = loc & 63, nb = within >> 5, c = within & 31;
  const int head = 2 * wn + (c >> 4), idx = 16 * nb + (c & 15);
  return head * 96 + 64 + idx;
}
DI int map_ukv(int n) {
  if (n < 256) return (n >> 6) * 128 + (n & 63);
  const int loc = n - 256; return (loc >> 6) * 128 + 64 + (loc & 63);
}

template <class SrcF>
DI void tr_tile(SrcF src, bf16_t* dst, int dstK, int n0, int k0, char* smem, int tid) {
  bf16_t* t = (bf16_t*)smem;
  const int nn = tid & 63, kq = tid >> 6;
  float tv[16];
#pragma unroll
  for (int i = 0; i < 16; ++i) tv[i] = src(k0 + kq + 4 * i, n0 + nn);
#pragma unroll
  for (int i = 0; i < 16; ++i) t[nn * 66 + kq + 4 * i] = f2bf(tv[i]);
  __syncthreads();
  const int n2 = tid >> 2, q = tid & 3;
  const unsigned* tw = (const unsigned*)t;
  u32x4 a, b;
  a.x = tw[n2 * 33 + 8 * q + 0]; a.y = tw[n2 * 33 + 8 * q + 1]; a.z = tw[n2 * 33 + 8 * q + 2]; a.w = tw[n2 * 33 + 8 * q + 3];
  b.x = tw[n2 * 33 + 8 * q + 4]; b.y = tw[n2 * 33 + 8 * q + 5]; b.z = tw[n2 * 33 + 8 * q + 6]; b.w = tw[n2 * 33 + 8 * q + 7];
  bf16_t* d = dst + (size_t)(n0 + n2) * dstK + k0 + 16 * q;
  *(u32x4*)d = a; *(u32x4*)(d + 8) = b;
  __syncthreads();
}


template <int SSTRIDE, int DSTK, class F>
DI void tr_stream(int n_items, F decode, char* smem, int tid) {
  const int nn = tid & 63, kq = tid >> 6, n2 = tid >> 2, q = tid & 3;
  float tn[16];
  const float* sp; bf16_t* dp;
  int it = blockIdx.x;
  if (it < n_items) { decode(it, sp, dp, kq, nn, n2, q);
#pragma unroll
    for (int i = 0; i < 16; ++i) tn[i] = sp[(size_t)(4 * i) * SSTRIDE]; }
  int buf = 0;
#pragma unroll 1
  for (; it < n_items; it += gridDim.x, buf ^= 1) {
    float tv[16];
#pragma unroll
    for (int i = 0; i < 16; ++i) tv[i] = tn[i];
    bf16_t* dcur = dp;
    if (it + (int)gridDim.x < n_items) { decode(it + gridDim.x, sp, dp, kq, nn, n2, q);
#pragma unroll
      for (int i = 0; i < 16; ++i) tn[i] = sp[(size_t)(4 * i) * SSTRIDE]; }
    bf16_t* t = (bf16_t*)smem + buf * 64 * 66;
#pragma unroll
    for (int i = 0; i < 16; ++i) t[nn * 66 + kq + 4 * i] = f2bf(tv[i]);
    __syncthreads();
    const unsigned* tw = (const unsigned*)t;
    u32x4 a, b;
    a.x = tw[n2 * 33 + 8 * q + 0]; a.y = tw[n2 * 33 + 8 * q + 1]; a.z = tw[n2 * 33 + 8 * q + 2]; a.w = tw[n2 * 33 + 8 * q + 3];
    b.x = tw[n2 * 33 + 8 * q + 4]; b.y = tw[n2 * 33 + 8 * q + 5]; b.z = tw[n2 * 33 + 8 * q + 6]; b.w = tw[n2 * 33 + 8 * q + 7];
    *(u32x4*)dcur = a; *(u32x4*)(dcur + 8) = b;
  }
  __syncthreads();
}

constexpr int PA_ADA = NL * 96;
constexpr int PA_WIN = NL * 40 * 16;
constexpr int PA_WOUT = NL * 16 * 16;
constexpr int PA_WUQ = NL * 6 * 4;
constexpr int PA_WUKV = NL * 8 * 2;
constexpr int PA_WR = NL * 2 * 16;
constexpr int PA_WGU = NL * 32 * 8 * 16;
constexpr int PA_WD = NL * 32 * 16 * 4;
constexpr int PA_H3 = NL * 64;
constexpr int PA_GEN = PA_ADA + PA_H3 + PA_WIN + PA_WOUT + PA_WUQ + PA_WUKV + PA_WR;

DI void phase_pa(const PV& p, char* smem, int tid) {
  const int lane = tid & 63, wid = tid >> 6;
  for (int it0 = blockIdx.x; it0 < PA_GEN; it0 += gridDim.x) {
    int it = it0;
    if (it < PA_ADA) {
      const int l = it / 96, ch = it % 96;
      float* cact = (float*)smem; float* red = (float*)(smem + 16384);
      const float* cin = (const float*)p.in[I_C];
      for (int i = tid; i < NB * 1024; i += 256) cact[i] = silu(cin[i]);
      __syncthreads();
      const float* W = (const float*)p.in[I_ADAW] + (size_t)l * 1024 * 6144 + ch * 64 + lane;
      float a0 = 0.f, a1 = 0.f, a2 = 0.f, a3 = 0.f;
      const int kb = wid * 256;
#pragma unroll 32
      for (int k = 0; k < 256; ++k) {
        const float w = W[(size_t)(kb + k) * 6144];
        a0 += cact[kb + k] * w; a1 += cact[1024 + kb + k] * w; a2 += cact[2048 + kb + k] * w; a3 += cact[3072 + kb + k] * w;
      }
      red[(wid * 4 + 0) * 64 + lane] = a0; red[(wid * 4 + 1) * 64 + lane] = a1; red[(wid * 4 + 2) * 64 + lane] = a2; red[(wid * 4 + 3) * 64 + lane] = a3;
      __syncthreads();
      {
        const int b = tid >> 6;
        const float v = red[(0 * 4 + b) * 64 + lane] + red[(1 * 4 + b) * 64 + lane] + red[(2 * 4 + b) * 64 + lane] + red[(3 * 4 + b) * 64 + lane]
                      + ((const float*)p.in[I_ADAB])[l * 6144 + ch * 64 + lane];
        ((float*)(p.ws + OFF_MOD))[(size_t)(l * NB + b) * 6144 + ch * 64 + lane] = v;
      }
      __syncthreads();
      continue;
    }
    it -= PA_ADA;
    if (it < PA_H3) {
      const int l = it >> 6, pos = tid & 127, half = tid >> 7, n = (it & 63) * 128 + pos;
      float* hbuf = (float*)smem;
      float* Wl = (float*)(smem + 128 * 65 * 4);
      const float* w1 = (const float*)p.in[I_HW1] + l * 33 * 64; const float* b1 = (const float*)p.in[I_HB1] + l * 64;
      const float* w2 = (const float*)p.in[I_HW2] + l * 64 * 64; const float* b2 = (const float*)p.in[I_HB2] + l * 64;
      const float* w3 = (const float*)p.in[I_HW3] + l * 64 * 64; const float* b3 = (const float*)p.in[I_HB3] + l * 64;
      const float* fr = (const float*)p.in[I_HFREQ] + l * 3 * 64;
      const float tt = (float)n / 8191.0f;
      const float w = 6.283185307179586f * (float)n / 8192.0f;
      auto loadW = [&](const float* wsrc, int n4) { for (int i = tid; i < n4; i += 256) ((f32x4*)Wl)[i] = ((const f32x4*)wsrc)[i]; };
      float* hrow = hbuf + pos * 65;
      if (half == 0) { hrow[0] = tt;
        for (int i = 0; i < 16; ++i) { const float f = 1e-4f + (float)i * ((15.0f - 1e-4f) / 15.0f); hrow[1 + i] = fast_cos(w * f); } }
      else { for (int i = 0; i < 16; ++i) { const float f = 1e-4f + (float)i * ((15.0f - 1e-4f) / 15.0f); hrow[17 + i] = -fast_sin(w * f); } }
      loadW(w1, 33 * 16);
      __syncthreads();
      float acc[32];
      auto layer = [&](int rows, const float* bias) {
#pragma unroll
        for (int j = 0; j < 32; ++j) acc[j] = bias[half * 32 + j];
#pragma unroll 4
        for (int i = 0; i < rows; ++i) { const float xv = hrow[i]; const f32x4* wr = (const f32x4*)(Wl + i * 64 + half * 32);
#pragma unroll
          for (int q = 0; q < 8; ++q) { const f32x4 wv = wr[q]; acc[4 * q] += xv * wv.x; acc[4 * q + 1] += xv * wv.y; acc[4 * q + 2] += xv * wv.z; acc[4 * q + 3] += xv * wv.w; } }
      };
      layer(33, b1);
      __syncthreads();
#pragma unroll
      for (int j = 0; j < 32; ++j) hrow[half * 32 + j] = fast_sin(fr[half * 32 + j] * acc[j]);
      loadW(w2, 64 * 16);
      __syncthreads();
      layer(64, b2);
      __syncthreads();
#pragma unroll
      for (int j = 0; j < 32; ++j) hrow[half * 32 + j] = fast_sin(fr[64 + half * 32 + j] * acc[j]);
      loadW(w3, 64 * 16);
      __syncthreads();
      layer(64, b3);
      bf16_t* oh = (bf16_t*)(p.ws + OFF_H3) + ((size_t)l * 2 * 8192 + n) * 64 + half * 32;
      bf16_t* ol = oh + (size_t)8192 * 64;
#pragma unroll
      for (int g = 0; g < 4; ++g) { unsigned ph[4], pl[4];
#pragma unroll
        for (int j = 0; j < 4; ++j) { const int c = 8 * g + 2 * j;
          const float v0 = fast_sin(fr[128 + half * 32 + c] * acc[c]), v1 = fast_sin(fr[128 + half * 32 + c + 1] * acc[c + 1]);
          ph[j] = pack2(v0, v1); pl[j] = pack2(v0 - lo_bf(ph[j]), v1 - hi_bf(ph[j])); }
        u32x4 a; a.x = ph[0]; a.y = ph[1]; a.z = ph[2]; a.w = ph[3]; *(u32x4*)(oh + 8 * g) = a;
        u32x4 bq; bq.x = pl[0]; bq.y = pl[1]; bq.z = pl[2]; bq.w = pl[3]; *(u32x4*)(ol + 8 * g) = bq; }
      __syncthreads();
      continue;
    }
    it -= PA_H3;
    if (it < PA_WIN) {
      const int l = it / 640, rem = it % 640, nt = rem >> 4, kt = rem & 15;
      const float* W = (const float*)p.in[I_WIN] + (size_t)l * 1024 * INC;
      tr_tile([&](int k, int n) { const int sc = map_in(n); return sc >= 0 ? W[(size_t)k * INC + sc] : 0.f; },
              (bf16_t*)(p.ws + OFF_WIN) + (size_t)l * NPAD * 1024, 1024, nt * 64, kt * 64, smem, tid);
      continue;
    }
    it -= PA_WIN;
    if (it < PA_WOUT) {
      const int l = it >> 8, rem = it & 255, nt = rem >> 4, kt = rem & 15;
      const float* W = (const float*)p.in[I_WOUT] + (size_t)l * 1024 * 1024;
      tr_tile([&](int k, int n) { return W[(size_t)k * 1024 + n]; }, (bf16_t*)(p.ws + OFF_WOUT) + (size_t)l * 1024 * 1024, 1024, nt * 64, kt * 64, smem, tid);
      continue;
    }
    it -= PA_WOUT;
    if (it < PA_WUQ) {
      const int l = it / 24, rem = it % 24, nt = rem >> 2, kt = rem & 3;
      const float* W = (const float*)p.in[I_WUQ] + (size_t)l * 256 * 384;
      const float* g = (const float*)p.in[I_QNORM] + l * 256;
      tr_tile([&](int k, int n) { return W[(size_t)k * 384 + map_uq(n)] * g[k]; }, (bf16_t*)(p.ws + OFF_WUQ) + (size_t)l * 384 * 256, 256, nt * 64, kt * 64, smem, tid);
      continue;
    }
    it -= PA_WUQ;
    if (it < PA_WUKV) {
      const int l = it >> 4, rem = it & 15, nt = rem >> 1, kt = rem & 1;
      const float* W = (const float*)p.in[I_WUKV] + (size_t)l * 128 * 512;
      const float* g = (const float*)p.in[I_KVNORM] + l * 128;
      tr_tile([&](int k, int n) { return W[(size_t)k * 512 + map_ukv(n)] * g[k]; }, (bf16_t*)(p.ws + OFF_WUKV) + (size_t)l * 512 * 128, 128, nt * 64, kt * 64, smem, tid);
      continue;
    }
    it -= PA_WUKV;
    if (it < PA_WR) {
      const int l = it >> 5, rem = it & 31, nt = rem >> 4, kt = rem & 15;
      const float* Wg = (const float*)p.in[I_RGW] + (size_t)l * 1024 * 4;
      const float* We = (const float*)p.in[I_REW] + (size_t)l * 1024 * 32;
      tr_tile([&](int k, int n) { return n < 4 ? Wg[(size_t)k * 4 + n] : (n < 36 ? We[(size_t)k * 32 + (n - 4)] : 0.f); },
              (bf16_t*)(p.ws + OFF_WR) + (size_t)l * 128 * 1024, 1024, nt * 64, kt * 64, smem, tid);
      continue;
    }
  }
  tr_stream<256, 1024>(PA_WGU, [&](int it, const float*& sp, bf16_t*& dp, int kq, int nn, int n2, int q) {
    const int le = it >> 7, rem = it & 127, nt = rem >> 4, kt = rem & 15;
    const int n = nt * 64 + nn; const int j = n >> 7, qq = (n >> 5) & 3, c = n & 31; const int col = 64 * j + 32 * (qq >> 1) + c;
    const float* W = (qq & 1) ? (const float*)p.in[I_MU] : (const float*)p.in[I_MG];
    sp = W + (size_t)le * 1024 * 256 + (size_t)(kt * 64 + kq) * 256 + col;
    dp = (bf16_t*)(p.ws + OFF_WGU) + (size_t)le * 512 * 1024 + (size_t)(nt * 64 + n2) * 1024 + kt * 64 + 16 * q; }, smem, tid);
  tr_stream<1024, 256>(PA_WD, [&](int it, const float*& sp, bf16_t*& dp, int kq, int nn, int n2, int q) {
    const int le = it >> 6, rem = it & 63, nt = rem >> 2, kt = rem & 3;
    sp = (const float*)p.in[I_MD] + (size_t)le * 256 * 1024 + (size_t)(kt * 64 + kq) * 1024 + nt * 64 + nn;
    dp = (bf16_t*)(p.ws + OFF_WD) + (size_t)le * 1024 * 256 + (size_t)(nt * 64 + n2) * 256 + kt * 64 + 16 * q; }, smem, tid);
}

DI void moe_bases(const unsigned* cnt, int* lbase  , int tid) {
  if (tid == 0) { int acc = 0; for (int e = 0; e < 32; ++e) { lbase[e] = acc; acc += ((int)cnt[e] + 127) & ~127; } lbase[32] = acc; }
  __syncthreads();
}

template <bool FINAL>
DI void phase_l0(const PV& p, int l, char* smem, int tid) {
  const int lane = tid & 63, wid = tid >> 6;
  int* lbase = (int*)smem;
  const unsigned* ctrl = (const unsigned*)(p.ws + OFF_CTRL);
  if (l > 0) moe_bases(ctrl + CT_CNT + (l - 1) * 32, lbase, tid);
  const float* mod = (const float*)(p.ws + OFF_MOD);
  const float* xin = (const float*)p.in[I_X];
  float* xres = p.out;
  bf16_t* XB = (bf16_t*)p.out;
  const bf16_t* Y = (const bf16_t*)(p.ws + OFF_Y);
  const int* toke = (const int*)(p.ws + OFF_TOKE);
  const int* tokp = (const int*)(p.ws + OFF_TOKP);
  bf16_t* H = (bf16_t*)(p.ws + OFF_H);
  const float* gw = FINAL ? (const float*)p.in[I_FINAL] : (const float*)p.in[I_LN1] + l * 1024;
  for (int row = blockIdx.x * 4 + wid; row < T; row += gridDim.x * 4) {
    const int b = row >> 13;
    f32x4 xv[4];
    if (l == 0) {
#pragma unroll
      for (int i = 0; i < 4; ++i) xv[i] = *(const f32x4*)(xin + (size_t)row * 1024 + lane * 4 + 256 * i);
    } else {
      const int e0 = toke[row * 2], e1 = toke[row * 2 + 1];
      const size_t s0 = (size_t)(lbase[e0] + tokp[row * 2]), s1 = (size_t)(lbase[e1] + tokp[row * 2 + 1]);
      const float* g2 = mod + (size_t)((l - 1) * NB + b) * 6144 + 5 * 1024;
#pragma unroll
      for (int i = 0; i < 4; ++i) {
        const int c = lane * 4 + 256 * i;
        const u32x2 xb = *(const u32x2*)(XB + (size_t)row * 2048 + c);
        f32x4 xr; xr.x = lo_bf(xb.x); xr.y = hi_bf(xb.x); xr.z = lo_bf(xb.y); xr.w = hi_bf(xb.y);
        const u32x2 y0 = *(const u32x2*)(Y + s0 * 1024 + c), y1 = *(const u32x2*)(Y + s1 * 1024 + c);
        const f32x4 g = *(const f32x4*)(g2 + c);
        xr.x += g.x * (lo_bf(y0.x) + lo_bf(y1.x)); xr.y += g.y * (hi_bf(y0.x) + hi_bf(y1.x));
        xr.z += g.z * (lo_bf(y0.y) + lo_bf(y1.y)); xr.w += g.w * (hi_bf(y0.y) + hi_bf(y1.y));
        xv[i] = xr;
      }
    }
    float ss = 0.f;
#pragma unroll
    for (int i = 0; i < 4; ++i) ss += xv[i].x * xv[i].x + xv[i].y * xv[i].y + xv[i].z * xv[i].z + xv[i].w * xv[i].w;
    ss = wave_sum(ss, lane);
    const float rstd = rsqrtf(ss * (1.0f / 1024.0f) + EPS);
    if (FINAL) {
#pragma unroll
      for (int i = 0; i < 4; ++i) {
        const int c = lane * 4 + 256 * i; const f32x4 g = *(const f32x4*)(gw + c);
        f32x4 o; o.x = xv[i].x * rstd * g.x; o.y = xv[i].y * rstd * g.y; o.z = xv[i].z * rstd * g.z; o.w = xv[i].w * rstd * g.w;
        *(f32x4*)(xres + (size_t)row * 1024 + c) = o;
      }
    } else {
      const float* sh = mod + (size_t)(l * NB + b) * 6144; const float* sc = sh + 1024;
#pragma unroll
      for (int i = 0; i < 4; ++i) {
        const int c = lane * 4 + 256 * i;
        { u32x2 xo; xo.x = pack2(xv[i].x, xv[i].y); xo.y = pack2(xv[i].z, xv[i].w); *(u32x2*)(XB + (size_t)row * 2048 + c) = xo; }
        const f32x4 g = *(const f32x4*)(gw + c), s1 = *(const f32x4*)(sc + c), s0 = *(const f32x4*)(sh + c);
        const float h0 = xv[i].x * rstd * g.x * (1.f + s1.x) + s0.x, h1 = xv[i].y * rstd * g.y * (1.f + s1.y) + s0.y;
        const float h2 = xv[i].z * rstd * g.z * (1.f + s1.z) + s0.z, h3 = xv[i].w * rstd * g.w * (1.f + s1.w) + s0.w;
        u32x2 o; o.x = pack2(h0, h1); o.y = pack2(h2, h3);
        *(u32x2*)(H + (size_t)row * 1024 + c) = o;
      }
    }
  }
}

DI void store4_bf(bf16_t* dst, float a, float b, float c, float d) { u32x2 o; o.x = pack2(a, b); o.y = pack2(c, d); *(u32x2*)dst = o; }

DI unsigned xcc_id() { return (unsigned)__builtin_amdgcn_s_getreg((3 << 11) | 20) & 0x7u; }
template <class NF, class F>
DI void xcd_queue_run(unsigned* qheads, char* smem, int wv, NF nitems, F f) {
  int* slot = (int*)(smem + LDS_BYTES - 16);
  const unsigned myx = xcc_id();
  for (int tries = 0; tries < 8;) {
    const unsigned x = (myx + tries) & 7u;
    const int n = nitems((int)x);
    __syncthreads();
    if (my_tid(wv) == 0) *slot = (int)atomicAdd(&qheads[x * 64], 1u);
    __syncthreads();
    const int idx = __builtin_amdgcn_readfirstlane(*slot);
    if (idx >= n) { ++tries; continue; }
    const int t = my_tid(wv);
    f((int)x, idx, t);
  }
}

DI void phase_l1(const PV& p, int l, char* smem, int wv) {
  const bf16_t* H = (const bf16_t*)(p.ws + OFF_H);
  const bf16_t* W = (const bf16_t*)(p.ws + OFF_WIN) + (size_t)l * NPAD * 1024;
  const int* pos = (const int*)p.in[I_POS];
  bf16_t* CA = (bf16_t*)(p.ws + OFF_CA);
  bf16_t* QS = (bf16_t*)(p.ws + OFF_QS); bf16_t* KS = (bf16_t*)(p.ws + OFF_KS); bf16_t* VST = (bf16_t*)(p.ws + OFF_VST);
  bf16_t* QD = (bf16_t*)(p.ws + OFF_QD); bf16_t* KD = (bf16_t*)(p.ws + OFF_KD); bf16_t* VDT = (bf16_t*)(p.ws + OFF_VDT);
  bf16_t* HY = (bf16_t*)(p.ws + OFF_HY);
  xcd_queue_run((unsigned*)(p.ws + OFF_CTRL) + CT_QHEAD + l * 8 * 64 + 1, smem, wv, [](int) { return 640; }, [&](int x, int idx, int tid) {
    const int mg = idx / 160, rem = idx % 160; const int nt = rem >> 3, mt = x * 32 + mg * 8 + (rem & 7);
    const int m0 = mt * 128;
    const bf16_t* A = H + (size_t)m0 * 1024;
    auto rowptr = [&](int row) { return A + (size_t)row * 1024; };
    const bf16_t* Bt = W + (size_t)nt * 128 * 1024;
    const bool transposed = (nt == 7) || (nt >= 12);
    if (!transposed) {
      gemm_tile<128, true>(rowptr, Bt, 1024, 1024, smem, tid, [&](f32x16 (&acc)[2][2], int wm, int wn, int r, int h) {
        if (nt < 4) {
#pragma unroll
          for (int mi = 0; mi < 2; ++mi) { const int tok = m0 + wm * 64 + mi * 32 + r;
#pragma unroll
            for (int ni = 0; ni < 2; ++ni)
#pragma unroll
              for (int g = 0; g < 4; ++g)
                store4_bf(CA + (size_t)tok * 512 + nt * 128 + wn * 64 + ni * 32 + 8 * g + 4 * h, acc[mi][ni][4 * g], acc[mi][ni][4 * g + 1], acc[mi][ni][4 * g + 2], acc[mi][ni][4 * g + 3]);
          }
        } else if (nt < 7) {
          const bool isq = nt < 6; const int head = isq ? (nt - 4) * 2 + wn : wn; const float scl = isq ? 0.125f * LOG2E : 1.0f;
#pragma unroll
          for (int mi = 0; mi < 2; ++mi) { const int tok = m0 + wm * 64 + mi * 32 + r; const int b = tok >> 13, s = tok & 8191; const float ps = (float)pos[tok];
            bf16_t* dst = isq ? QS + ((size_t)(b * 4 + head) * S + s) * 64 : KS + ((size_t)(b * 2 + head) * S + s) * 64;
#pragma unroll
            for (int g = 0; g < 4; ++g) { float o1[4], o2[4];
#pragma unroll
              for (int e = 0; e < 4; ++e) { const int c = 8 * g + 4 * h + e; float sn, cs; rope_sincos(ps, c, 32, sn, cs);
                const float x1 = acc[mi][0][4 * g + e], x2 = acc[mi][1][4 * g + e]; o1[e] = (x1 * cs - x2 * sn) * scl; o2[e] = (x1 * sn + x2 * cs) * scl; }
              store4_bf(dst + 8 * g + 4 * h, o1[0], o1[1], o1[2], o1[3]); store4_bf(dst + 32 + 8 * g + 4 * h, o2[0], o2[1], o2[2], o2[3]); }
          }
        } else {
          const bool isq = nt < 10; const int head = (isq ? nt - 8 : nt - 10) * 2 + wn; const float scl = isq ? 0.17677669529663687f * LOG2E : 1.0f;
#pragma unroll
          for (int mi = 0; mi < 2; ++mi) { const int tok = m0 + wm * 64 + mi * 32 + r; const int b = tok >> 13, s = tok & 8191; const float ps = (float)pos[tok];
            bf16_t* dst = (isq ? QD : KD) + ((size_t)(b * 4 + head) * S + s) * 64;
#pragma unroll
            for (int g = 0; g < 4; ++g) { float o1[4], o2[4]; const int which = g >> 1;
#pragma unroll
              for (int e = 0; e < 4; ++e) { const int i = 8 * (g & 1) + 4 * h + e; float sn, cs; rope_sincos(ps, i, 16, sn, cs);
                const float x1 = acc[mi][0][4 * g + e], x2 = acc[mi][1][4 * g + e]; o1[e] = (x1 * cs - x2 * sn) * scl; o2[e] = (x1 * sn + x2 * cs) * scl; }
              const int i0 = 8 * (g & 1) + 4 * h;
              store4_bf(dst + which * 32 + i0, o1[0], o1[1], o1[2], o1[3]); store4_bf(dst + which * 32 + 16 + i0, o2[0], o2[1], o2[2], o2[3]); }
          }
        }
      });
    } else {
      gemm_tile<128, false>(rowptr, Bt, 1024, 1024, smem, tid, [&](f32x16 (&acc)[2][2], int wm, int wn, int r, int h) {
#pragma unroll
        for (int mi = 0; mi < 2; ++mi) { const int tb = m0 + wm * 64 + mi * 32; const int b = tb >> 13, sb = tb & 8191;
#pragma unroll
          for (int ni = 0; ni < 2; ++ni) {
            bf16_t* dst; bool perm = true;
            if (nt == 7) dst = VST + ((size_t)(b * 2 + wn) * 64 + ni * 32 + r) * S + sb;
            else if (nt < 14) dst = VDT + ((size_t)(b * 4 + (nt - 12) * 2 + wn) * 64 + ni * 32 + r) * S + sb;
            else { dst = HY + ((size_t)b * 768 + (nt - 14) * 128 + wn * 64 + ni * 32 + r) * S + sb; perm = false; }
#pragma unroll
            for (int g = 0; g < 4; ++g) {
              const int off = perm ? 16 * (g >> 1) + 8 * h + 4 * (g & 1) : 8 * g + 4 * h;
              store4_bf(dst + off, acc[mi][ni][4 * g], acc[mi][ni][4 * g + 1], acc[mi][ni][4 * g + 2], acc[mi][ni][4 * g + 3]);
            }
          }
        }
      });
    }
  });
}

DI void phase_l1b(const PV& p, int l, char* smem, int tid) {
  const bf16_t* CA = (const bf16_t*)(p.ws + OFF_CA);
  const bf16_t* WUQ = (const bf16_t*)(p.ws + OFF_WUQ) + (size_t)l * 384 * 256;
  const bf16_t* WUKV = (const bf16_t*)(p.ws + OFF_WUKV) + (size_t)l * 512 * 128;
  const int* pos = (const int*)p.in[I_POS];
  bf16_t* QM = (bf16_t*)(p.ws + OFF_QM); bf16_t* KM = (bf16_t*)(p.ws + OFF_KM); bf16_t* VMT = (bf16_t*)(p.ws + OFF_VMT);
  float* rq = (float*)(smem + 73728); float* rkv = rq + 64;
  const float qscl = 0.10206207261596577f * LOG2E;
  for (int mt = blockIdx.x; mt < 512; mt += gridDim.x) {
    const int m0 = mt * 64;
    {
      const int row = tid >> 2, q = tid & 3, lane = tid & 63;
      const bf16_t* src = CA + (size_t)(m0 + row) * 512;
      float s1 = 0.f, s2 = 0.f;
#pragma unroll
      for (int i = 0; i < 8; ++i) { const u32x4 v = *(const u32x4*)(src + q * 64 + i * 8);
        s1 += lo_bf(v.x) * lo_bf(v.x) + hi_bf(v.x) * hi_bf(v.x) + lo_bf(v.y) * lo_bf(v.y) + hi_bf(v.y) * hi_bf(v.y) + lo_bf(v.z) * lo_bf(v.z) + hi_bf(v.z) * hi_bf(v.z) + lo_bf(v.w) * lo_bf(v.w) + hi_bf(v.w) * hi_bf(v.w); }
#pragma unroll
      for (int i = 0; i < 4; ++i) { const u32x4 v = *(const u32x4*)(src + 256 + q * 32 + i * 8);
        s2 += lo_bf(v.x) * lo_bf(v.x) + hi_bf(v.x) * hi_bf(v.x) + lo_bf(v.y) * lo_bf(v.y) + hi_bf(v.y) * hi_bf(v.y) + lo_bf(v.z) * lo_bf(v.z) + hi_bf(v.z) * hi_bf(v.z) + lo_bf(v.w) * lo_bf(v.w) + hi_bf(v.w) * hi_bf(v.w); }
      s1 += shx(s1, 1, lane); s1 += shx(s1, 2, lane); s2 += shx(s2, 1, lane); s2 += shx(s2, 2, lane);
      if (q == 0) { rq[row] = rsqrtf(s1 * (1.0f / 256.0f) + EPS); rkv[row] = rsqrtf(s2 * (1.0f / 128.0f) + EPS); }
    }
    __syncthreads();
    const bf16_t* A = CA + (size_t)m0 * 512;
    for (int nt = 0; nt < 3; ++nt) {
      gemm_tile<64, true>([&](int row) { return A + (size_t)row * 512; }, WUQ + (size_t)nt * 128 * 256, 256, 256, smem, tid,
        [&](f32x16 (&acc)[1][2], int wm, int wn, int r, int h) {
          const int lrow = wm * 32 + r, tok = m0 + lrow; const int b = tok >> 13, s = tok & 8191; const float sc = rq[lrow] * qscl;
          if (nt < 2) { const int head = nt * 2 + wn; bf16_t* dst = QM + ((size_t)(b * 4 + head) * S + s) * 96;
#pragma unroll
            for (int ni = 0; ni < 2; ++ni)
#pragma unroll
              for (int g = 0; g < 4; ++g) store4_bf(dst + ni * 32 + 8 * g + 4 * h, acc[0][ni][4 * g] * sc, acc[0][ni][4 * g + 1] * sc, acc[0][ni][4 * g + 2] * sc, acc[0][ni][4 * g + 3] * sc);
          } else { const float ps = (float)pos[tok];
#pragma unroll
            for (int g = 0; g < 4; ++g) { const int head = 2 * wn + (g >> 1); bf16_t* dst = QM + ((size_t)(b * 4 + head) * S + s) * 96 + 64; float o1[4], o2[4];
#pragma unroll
              for (int e = 0; e < 4; ++e) { const int i = 8 * (g & 1) + 4 * h + e; float sn, cs; rope_sincos(ps, i, 16, sn, cs);
                const float x1 = acc[0][0][4 * g + e] * sc, x2 = acc[0][1][4 * g + e] * sc; o1[e] = x1 * cs - x2 * sn; o2[e] = x1 * sn + x2 * cs; }
              const int i0 = 8 * (g & 1) + 4 * h;
              store4_bf(dst + i0, o1[0], o1[1], o1[2], o1[3]); store4_bf(dst + 16 + i0, o2[0], o2[1], o2[2], o2[3]); }
          }
        });
    }
    for (int nt = 0; nt < 2; ++nt) {
      gemm_tile<64, true>([&](int row) { return A + (size_t)row * 512 + 256; }, WUKV + (size_t)nt * 128 * 128, 128, 128, smem, tid,
        [&](f32x16 (&acc)[1][2], int wm, int wn, int r, int h) {
          const int lrow = wm * 32 + r, tok = m0 + lrow; const int b = tok >> 13, s = tok & 8191; const float sc = rkv[lrow];
          const int head = nt * 2 + wn; bf16_t* dst = KM + ((size_t)(b * 4 + head) * S + s) * 96;
#pragma unroll
          for (int ni = 0; ni < 2; ++ni)
#pragma unroll
            for (int g = 0; g < 4; ++g) store4_bf(dst + ni * 32 + 8 * g + 4 * h, acc[0][ni][4 * g] * sc, acc[0][ni][4 * g + 1] * sc, acc[0][ni][4 * g + 2] * sc, acc[0][ni][4 * g + 3] * sc);
        });
    }
    for (int nt = 2; nt < 4; ++nt) {
      gemm_tile<64, false>([&](int row) { return A + (size_t)row * 512 + 256; }, WUKV + (size_t)nt * 128 * 128, 128, 128, smem, tid,
        [&](f32x16 (&acc)[1][2], int wm, int wn, int r, int h) {
          const int tb = m0 + wm * 32; const int b = tb >> 13, sb = tb & 8191; const int head = (nt - 2) * 2 + wn;
#pragma unroll
          for (int ni = 0; ni < 2; ++ni) { bf16_t* dst = VMT + ((size_t)(b * 4 + head) * 64 + ni * 32 + r) * S + sb;
#pragma unroll
            for (int g = 0; g < 4; ++g) { const float* rk = rkv + wm * 32 + 8 * g + 4 * h;
              store4_bf(dst + 16 * (g >> 1) + 8 * h + 4 * (g & 1), acc[0][ni][4 * g] * rk[0], acc[0][ni][4 * g + 1] * rk[1], acc[0][ni][4 * g + 2] * rk[2], acc[0][ni][4 * g + 3] * rk[3]); }
          }
        });
    }
#pragma unroll
    for (int j = 0; j < 4; ++j) {
      const int idx = tid + 256 * j, lrow = idx >> 4, i = idx & 15, tok = m0 + lrow; const int b = tok >> 13, s = tok & 8191;
      const float x1 = bf2f(CA[(size_t)tok * 512 + 384 + i]), x2 = bf2f(CA[(size_t)tok * 512 + 400 + i]);
      float sn, cs; rope_sincos((float)pos[tok], i, 16, sn, cs);
      const bf16_t o1 = f2bf(x1 * cs - x2 * sn), o2 = f2bf(x1 * sn + x2 * cs);
#pragma unroll
      for (int hd = 0; hd < 4; ++hd) { bf16_t* dst = KM + ((size_t)(b * 4 + hd) * S + s) * 96 + 64; dst[i] = o1; dst[16 + i] = o2; }
    }
    __syncthreads();
  }
}

DI float vmaxq(float a, float b) { return __builtin_amdgcn_fmed3f(a, b, __builtin_inff()); }

template <int DQ, int NMAP, bool BAND>
DI void attn_core(const bf16_t* __restrict__ Q, const bf16_t* __restrict__ K, const bf16_t* __restrict__ Vt, int q0, int k_lo, int k_hi,
                  float m_init, float l_init, f32x16 (&O)[NMAP][2], float (&lsum)[NMAP], char* smem, int tid) {
  constexpr int DK = DQ / NMAP, KS = DK / 16, PK = DQ + 8, KCH = DQ / 8 * 64 / 256;
  bf16_t* Ks = (bf16_t*)smem;
  bf16_t* Vs = Ks + 2 * 64 * PK;
  const int lane = tid & 63, wid = tid >> 6, r = lane & 31, h = lane >> 5;
  bf16x8 qf[DQ / 16];
  { const bf16_t* qp = Q + (size_t)(q0 + wid * 32 + r) * DQ + 8 * h;
#pragma unroll
    for (int ks = 0; ks < DQ / 16; ++ks) qf[ks] = *(const bf16x8*)(qp + ks * 16); }
  float m[NMAP];
  f32x16 negm[NMAP];
#pragma unroll
  for (int mp = 0; mp < NMAP; ++mp) { m[mp] = m_init; lsum[mp] = (h == 0) ? l_init : 0.f;
#pragma unroll
    for (int d = 0; d < 2; ++d)
#pragma unroll
      for (int i = 0; i < 16; ++i) O[mp][d][i] = 0.f; }
  u32x4 rk[KCH], rv[2];
  const int vrow = tid >> 3, vkc = tid & 7;
  auto gload = [&](int kt0) {
#pragma unroll
    for (int i = 0; i < KCH; ++i) rk[i] = *(const u32x4*)(K + (size_t)kt0 * DQ + (size_t)(tid + 256 * i) * 8);
#pragma unroll
    for (int i = 0; i < 2; ++i) rv[i] = *(const u32x4*)(Vt + (size_t)(vrow + 32 * i) * S + kt0 + vkc * 8);
  };
  auto lstore = [&](int buf) {
#pragma unroll
    for (int i = 0; i < KCH; ++i) { const int c = tid + 256 * i, row = c / (DQ / 8), kc = c % (DQ / 8); *(u32x4*)(Ks + (buf * 64 + row) * PK + kc * 8) = rk[i]; }
#pragma unroll
    for (int i = 0; i < 2; ++i) *(u32x4*)(Vs + (buf * 64 + vrow + 32 * i) * 72 + vkc * 8) = rv[i];
  };
  const int qpos = q0 + wid * 32 + r;
  auto tile = [&](int kt0, int buf, auto first_tag) {
    constexpr bool FIRST = decltype(first_tag)::value;
    const bf16_t* Kb = Ks + (buf * 64 + r) * PK + 8 * h;
    const bf16_t* Vb = Vs + (buf * 64 + r) * 72 + 8 * h;
#pragma unroll
    for (int mp = 0; mp < NMAP; ++mp) {
      f32x16 sc[2];
      auto qk = [&]() {
#pragma unroll
        for (int kb = 0; kb < 2; ++kb) {
          if (FIRST) {
#pragma unroll
            for (int i = 0; i < 16; ++i) sc[kb][i] = 0.f;
          } else sc[kb] = negm[mp];
#pragma unroll
          for (int ks = 0; ks < KS; ++ks) { const bf16x8 kf = *(const bf16x8*)(Kb + kb * 32 * PK + (mp * KS + ks) * 16); sc[kb] = MFMA32(kf, qf[mp * KS + ks], sc[kb]); }
        }
        if (BAND) {
#pragma unroll
          for (int kb = 0; kb < 2; ++kb)
#pragma unroll
            for (int i = 0; i < 16; ++i) { const int dlt = kt0 + kb * 32 + crow(i, h) - qpos; if (dlt > 128 || dlt < -128) sc[kb][i] = -1e30f; }
        }
      };
      auto expsum = [&]() {
        f32x2 ps2a = {0.f, 0.f}, ps2b = {0.f, 0.f};
#pragma unroll
        for (int kb = 0; kb < 2; ++kb)
#pragma unroll
          for (int i = 0; i < 16; i += 2) { const f32x2 pv = {__builtin_amdgcn_exp2f(sc[kb][i]), __builtin_amdgcn_exp2f(sc[kb][i + 1])}; sc[kb][i] = pv.x; sc[kb][i + 1] = pv.y;
            if (i & 2) ps2a += pv; else ps2b += pv; }
        const f32x2 t = ps2a + ps2b; return t.x + t.y;
      };
      qk();
      float ps;
      if (FIRST) {
        float mx = vmaxq(sc[0][0], sc[1][0]);
#pragma unroll
        for (int i = 1; i < 16; ++i) mx = vmaxq(vmaxq(mx, sc[0][i]), sc[1][i]);
        mx = fmaxf(mx, shx(mx, 32, lane));
        const float mnew = fmaxf(m[mp], mx);
        lsum[mp] *= __builtin_amdgcn_exp2f(m[mp] - mnew);
        m[mp] = mnew;
#pragma unroll
        for (int i = 0; i < 16; ++i) { negm[mp][i] = -mnew; sc[0][i] -= mnew; sc[1][i] -= mnew; }
        ps = expsum();
      } else {
        ps = expsum();
        if (__builtin_amdgcn_ballot_w64(!(ps <= 65536.0f)) != 0ull) {
          qk();
          float mx = vmaxq(sc[0][0], sc[1][0]);
#pragma unroll
          for (int i = 1; i < 16; ++i) mx = vmaxq(vmaxq(mx, sc[0][i]), sc[1][i]);
          mx = fmaxf(mx, shx(mx, 32, lane));
          const float dl = fmaxf(mx, 0.f);
          const float alpha = __builtin_amdgcn_exp2f(-dl);
          m[mp] += dl; lsum[mp] *= alpha;
#pragma unroll
          for (int i = 0; i < 16; ++i) { negm[mp][i] -= dl; sc[0][i] -= dl; sc[1][i] -= dl; }
#pragma unroll
          for (int d = 0; d < 2; ++d)
#pragma unroll
            for (int i = 0; i < 16; ++i) O[mp][d][i] *= alpha;
          ps = expsum();
        }
      }
      lsum[mp] += ps;
#pragma unroll
      for (int kb = 0; kb < 2; ++kb)
#pragma unroll
        for (int s2 = 0; s2 < 2; ++s2) {
          u32x4 pw; pw.x = pack2(sc[kb][8 * s2 + 0], sc[kb][8 * s2 + 1]); pw.y = pack2(sc[kb][8 * s2 + 2], sc[kb][8 * s2 + 3]);
          pw.z = pack2(sc[kb][8 * s2 + 4], sc[kb][8 * s2 + 5]); pw.w = pack2(sc[kb][8 * s2 + 6], sc[kb][8 * s2 + 7]);
          const bf16x8 pf = __builtin_bit_cast(bf16x8, pw);
#pragma unroll
          for (int d = 0; d < 2; ++d) { const bf16x8 vf = *(const bf16x8*)(Vb + d * 32 * 72 + kb * 32 + s2 * 16); O[mp][d] = MFMA32(vf, pf, O[mp][d]); }
        }
    }
  };
  gload(k_lo); lstore(0); __syncthreads();
  {
    const bool more = k_lo + 64 < k_hi;
    if (more) gload(k_lo + 64);
    tile(k_lo, 0, std::true_type{});
    if (more) lstore(1);
    __syncthreads();
  }
  int buf = 1;
  for (int kt0 = k_lo + 64; kt0 < k_hi; kt0 += 64, buf ^= 1) {
    const bool more = kt0 + 64 < k_hi;
    if (more) gload(kt0 + 64);
    tile(kt0, buf, std::false_type{});
    if (more) lstore(buf ^ 1);
    __syncthreads();
  }
#pragma unroll
  for (int mp = 0; mp < NMAP; ++mp) lsum[mp] += shx(lsum[mp], 32, lane);
}

template <int DQ, bool BAND>
DI void attn_core_pipe(const bf16_t* __restrict__ Q, const bf16_t* __restrict__ K, const bf16_t* __restrict__ Vt, int q0, int k_lo, int k_hi,
                       float m_init, float l_init, f32x16 (&O)[2], float& lsum_out, char* smem, int tid) {
  constexpr int KS = DQ / 16, PK = DQ + 8, KCH = DQ / 8 * 64 / 256;
  bf16_t* Ks = (bf16_t*)smem;
  bf16_t* Vs = Ks + 2 * 64 * PK;
  const int lane = tid & 63, wid = tid >> 6, r = lane & 31, h = lane >> 5;
  bf16x8 qf[KS];
  { const bf16_t* qp = Q + (size_t)(q0 + wid * 32 + r) * DQ + 8 * h;
#pragma unroll
    for (int ks = 0; ks < KS; ++ks) qf[ks] = *(const bf16x8*)(qp + ks * 16); }
  float m = m_init, lsum = (h == 0) ? l_init : 0.f;
  f32x16 negm;
#pragma unroll
  for (int d = 0; d < 2; ++d)
#pragma unroll
    for (int i = 0; i < 16; ++i) O[d][i] = 0.f;
  u32x4 rk[KCH], rv[2];
  const int vrow = tid >> 3, vkc = tid & 7;
  auto gloadK = [&](int kt0) {
#pragma unroll
    for (int i = 0; i < KCH; ++i) rk[i] = *(const u32x4*)(K + (size_t)kt0 * DQ + (size_t)(tid + 256 * i) * 8);
  };
  auto gloadV = [&](int kt0) {
#pragma unroll
    for (int i = 0; i < 2; ++i) rv[i] = *(const u32x4*)(Vt + (size_t)(vrow + 32 * i) * S + kt0 + vkc * 8);
  };
  auto lstoreK = [&](int buf) {
#pragma unroll
    for (int i = 0; i < KCH; ++i) { const int c = tid + 256 * i, row = c / (DQ / 8), kc = c % (DQ / 8); *(u32x4*)(Ks + (buf * 64 + row) * PK + kc * 8) = rk[i]; }
  };
  auto lstoreV = [&](int buf) {
#pragma unroll
    for (int i = 0; i < 2; ++i) *(u32x4*)(Vs + (buf * 64 + vrow + 32 * i) * 72 + vkc * 8) = rv[i];
  };
  auto qk = [&](f32x16 (&sc)[2], int buf, bool zero = false) {
    const bf16_t* Kb = Ks + (buf * 64 + r) * PK + 8 * h;
    bf16x8 kf[2][KS];
#pragma unroll
    for (int ks = 0; ks < KS; ++ks) kf[0][ks] = *(const bf16x8*)(Kb + ks * 16);
#pragma unroll
    for (int ks = 0; ks < KS; ++ks) kf[1][ks] = *(const bf16x8*)(Kb + 32 * PK + ks * 16);
    __builtin_amdgcn_sched_barrier(0);
#pragma unroll
    for (int kb = 0; kb < 2; ++kb) {
      if (zero) {
#pragma unroll
        for (int i = 0; i < 16; ++i) sc[kb][i] = 0.f;
      } else sc[kb] = negm;
#pragma unroll
      for (int ks = 0; ks < KS; ++ks) sc[kb] = MFMA32(kf[kb][ks], qf[ks], sc[kb]);
    }
  };
  const int qpos = q0 + wid * 32 + r;
  auto mask = [&](f32x16 (&sc)[2], int kt0) {
    if (BAND) {
#pragma unroll
      for (int kb = 0; kb < 2; ++kb)
#pragma unroll
        for (int i = 0; i < 16; ++i) { const int dlt = kt0 + kb * 32 + crow(i, h) - qpos; if (dlt > 128 || dlt < -128) sc[kb][i] = -1e30f; }
    }
  };
  auto expsum = [&](f32x16 (&sc)[2]) {
    f32x2 ps2a = {0.f, 0.f}, ps2b = {0.f, 0.f};
#pragma unroll
    for (int kb = 0; kb < 2; ++kb)
#pragma unroll
      for (int i = 0; i < 16; i += 2) { const f32x2 pv = {__builtin_amdgcn_exp2f(sc[kb][i]), __builtin_amdgcn_exp2f(sc[kb][i + 1])}; sc[kb][i] = pv.x; sc[kb][i + 1] = pv.y;
        if (i & 2) ps2a += pv; else ps2b += pv; }
    const f32x2 t = ps2a + ps2b; return t.x + t.y;
  };
  auto smpv = [&](f32x16 (&sc)[2], f32x16 (&nxt)[2], bool has1, int kt0, int buf) {
    mask(sc, kt0);
    if (has1) qk(nxt, buf ^ 1);
    float ps = expsum(sc);
    if (__builtin_amdgcn_ballot_w64(!(ps <= 65536.0f)) != 0ull) {
      {
        const bf16_t* Kg = K + (size_t)(kt0 + r) * DQ + 8 * h;
#pragma unroll
        for (int kb = 0; kb < 2; ++kb) { sc[kb] = negm;
#pragma unroll
          for (int ks = 0; ks < KS; ++ks) { const bf16x8 kf = *(const bf16x8*)(Kg + (size_t)kb * 32 * DQ + ks * 16); sc[kb] = MFMA32(kf, qf[ks], sc[kb]); } }
      }
      mask(sc, kt0);
      float mx = vmaxq(sc[0][0], sc[1][0]);
#pragma unroll
      for (int i = 1; i < 16; ++i) mx = vmaxq(vmaxq(mx, sc[0][i]), sc[1][i]);
      mx = fmaxf(mx, shx(mx, 32, lane));
      const float dl = fmaxf(mx, 0.f);
      const float alpha = __builtin_amdgcn_exp2f(-dl);
      m += dl; lsum *= alpha;
#pragma unroll
      for (int i = 0; i < 16; ++i) { negm[i] -= dl; sc[0][i] -= dl; sc[1][i] -= dl; }
      if (has1) {
#pragma unroll
        for (int i = 0; i < 16; ++i) { nxt[0][i] -= dl; nxt[1][i] -= dl; }
      }
#pragma unroll
      for (int d = 0; d < 2; ++d)
#pragma unroll
        for (int i = 0; i < 16; ++i) O[d][i] *= alpha;
      ps = expsum(sc);
    }
    lsum += ps;
    const bf16_t* Vb = Vs + (buf * 64 + r) * 72 + 8 * h;
    bf16x8 vf[2][2][2];
#pragma unroll
    for (int kb = 0; kb < 2; ++kb)
#pragma unroll
      for (int s2 = 0; s2 < 2; ++s2)
#pragma unroll
        for (int d = 0; d < 2; ++d) vf[kb][s2][d] = *(const bf16x8*)(Vb + d * 32 * 72 + kb * 32 + s2 * 16);
#pragma unroll
    for (int kb = 0; kb < 2; ++kb)
#pragma unroll
      for (int s2 = 0; s2 < 2; ++s2) {
        u32x4 pw; pw.x = pack2(sc[kb][8 * s2 + 0], sc[kb][8 * s2 + 1]); pw.y = pack2(sc[kb][8 * s2 + 2], sc[kb][8 * s2 + 3]);
        pw.z = pack2(sc[kb][8 * s2 + 4], sc[kb][8 * s2 + 5]); pw.w = pack2(sc[kb][8 * s2 + 6], sc[kb][8 * s2 + 7]);
        const bf16x8 pf = __builtin_bit_cast(bf16x8, pw);
#pragma unroll
        for (int d = 0; d < 2; ++d) O[d] = MFMA32(vf[kb][s2][d], pf, O[d]);
      }
    __builtin_amdgcn_sched_group_barrier(0x100, 8, 0);
#pragma unroll
    for (int g = 0; g < 4; ++g) { __builtin_amdgcn_sched_group_barrier(0x002, 4, 0); __builtin_amdgcn_sched_group_barrier(0x008, 2, 0); }
  };
  gloadK(k_lo); gloadV(k_lo); lstoreK(0); lstoreV(0);
  if (k_lo + 64 < k_hi) { gloadK(k_lo + 64); lstoreK(1); }
  __syncthreads();
  f32x16 scA[2], scB[2];
  qk(scA, 0, true);
  {
    mask(scA, k_lo);
    float mx = vmaxq(scA[0][0], scA[1][0]);
#pragma unroll
    for (int i = 1; i < 16; ++i) mx = vmaxq(vmaxq(mx, scA[0][i]), scA[1][i]);
    mx = fmaxf(mx, shx(mx, 32, lane));
    const float mnew = fmaxf(m, mx);
    lsum *= __builtin_amdgcn_exp2f(m - mnew);
    m = mnew;
#pragma unroll
    for (int i = 0; i < 16; ++i) { negm[i] = -mnew; scA[0][i] -= mnew; scA[1][i] -= mnew; }
  }
  __syncthreads();
  auto step = [&](f32x16 (&cur)[2], f32x16 (&nxt)[2], int kt0, int par, bool first) {
    const bool has1 = kt0 + 64 < k_hi, has2 = kt0 + 128 < k_hi;
    if (has2) gloadK(kt0 + 128);
    if (has1) gloadV(kt0 + 64);
    smpv(cur, nxt, has1, kt0, par);
    if (has2) lstoreK(par);
    if (has1) lstoreV(par ^ 1);
    __syncthreads();
  };
  step(scA, scB, k_lo, 0, true);
  int kt0 = k_lo + 64;
  for (; kt0 + 64 < k_hi; kt0 += 128) { step(scB, scA, kt0, 1, false); step(scA, scB, kt0 + 64, 0, false); }
  if (kt0 < k_hi) step(scB, scA, kt0, 1, false);
  lsum += shx(lsum, 32, lane);
  lsum_out = lsum;
}

DI void attn_store(bf16_t* MIX, int tok, int coloff, const f32x16 (&O)[2], float scale, int h) {
#pragma unroll
  for (int d = 0; d < 2; ++d)
#pragma unroll
    for (int g = 0; g < 4; ++g)
      store4_bf(MIX + (size_t)tok * 1024 + coloff + d * 32 + 8 * g + 4 * h, O[d][4 * g] * scale, O[d][4 * g + 1] * scale, O[d][4 * g + 2] * scale, O[d][4 * g + 3] * scale);
}

DI void mla_item(const PV& p, int bh, int qb, char* smem, int tid) {
  const bf16_t* Q = (const bf16_t*)(p.ws + OFF_QM) + (size_t)bh * S * 96;
  const bf16_t* K = (const bf16_t*)(p.ws + OFF_KM) + (size_t)bh * S * 96;
  const bf16_t* Vt = (const bf16_t*)(p.ws + OFF_VMT) + (size_t)bh * 64 * S;
  f32x16 O[1][2]; float ls[1];
  attn_core_pipe<96, false>(Q, K, Vt, qb * 128, 0, S, -INFINITY, 0.f, O[0], ls[0], smem, tid);
  const int lane = tid & 63, wid = tid >> 6, r = lane & 31, h = lane >> 5;
  const int b = bh >> 2, hd = bh & 3;
  attn_store((bf16_t*)(p.ws + OFF_MIX), b * S + qb * 128 + wid * 32 + r, hd * 64, O[0], 1.0f / ls[0], h);
}

DI void swa_item(const PV& p, int l, int bh, int qb, char* smem, int tid) {
  const int b = bh >> 2, hd = bh & 3, hk = hd >> 1;
  const bf16_t* Q = (const bf16_t*)(p.ws + OFF_QS) + (size_t)bh * S * 64;
  const bf16_t* K = (const bf16_t*)(p.ws + OFF_KS) + (size_t)(b * 2 + hk) * S * 64;
  const bf16_t* Vt = (const bf16_t*)(p.ws + OFF_VST) + (size_t)(b * 2 + hk) * 64 * S;
  const int q0 = qb * 128;
  const int k_lo = q0 - 128 < 0 ? 0 : q0 - 128, k_hi = q0 + 256 > S ? S : q0 + 256;
  const float sink = ((const float*)p.in[I_SINK])[l * 4 + hd] * LOG2E;
  f32x16 O[1][2]; float ls[1];
  attn_core_pipe<64, true>(Q, K, Vt, q0, k_lo, k_hi, sink, 1.0f, O[0], ls[0], smem, tid);
  const int lane = tid & 63, wid = tid >> 6, r = lane & 31, h = lane >> 5;
  attn_store((bf16_t*)(p.ws + OFF_MIX), b * S + q0 + wid * 32 + r, 256 + hd * 64, O[0], 1.0f / ls[0], h);
}

DI void diff_item(const PV& p, int l, int bh, int qb, char* smem, int tid) {
  const bf16_t* Q = (const bf16_t*)(p.ws + OFF_QD) + (size_t)bh * S * 64;
  const bf16_t* K = (const bf16_t*)(p.ws + OFF_KD) + (size_t)bh * S * 64;
  const bf16_t* Vt = (const bf16_t*)(p.ws + OFF_VDT) + (size_t)bh * 64 * S;
  f32x16 O[2][2]; float ls[2];
  attn_core<64, 2, false>(Q, K, Vt, qb * 128, 0, S, -INFINITY, 0.f, O, ls, smem, tid);
  const int lane = tid & 63, wid = tid >> 6, r = lane & 31, h = lane >> 5;
  const int b = bh >> 2, hd = bh & 3;
  asm volatile("" : "+s"(l));
  const float* lv = (const float*)p.in[I_LAMBDA] + l * 128;
  float d01 = 0.f, d23 = 0.f;
  for (int i = 0; i < 32; ++i) { d01 += lv[i] * lv[32 + i]; d23 += lv[64 + i] * lv[96 + i]; }
  const float lambda_init = 0.8f - 0.6f * expf(-0.3f * (float)l);
  const float lam = expf(d01) - expf(d23) + lambda_init;
  const float i1 = 1.0f / ls[0], i2 = lam / ls[1];
  const float* ng = (const float*)p.in[I_DNORM] + l * 64;
  f32x16 o[2]; float ss = 0.f;
#pragma unroll
  for (int d = 0; d < 2; ++d)
#pragma unroll
    for (int i = 0; i < 16; ++i) { const float v = O[0][d][i] * i1 - O[1][d][i] * i2; o[d][i] = v; ss += v * v; }
  ss += shx(ss, 32, lane);
  const float rstd = rsqrtf(ss * (1.0f / 64.0f) + EPS) * (1.0f - lambda_init);
#pragma unroll
  for (int d = 0; d < 2; ++d)
#pragma unroll
    for (int i = 0; i < 16; ++i) o[d][i] *= ng[d * 32 + crow(i, h)];
  attn_store((bf16_t*)(p.ws + OFF_MIX), b * S + qb * 128 + wid * 32 + r, 512 + hd * 64, o, rstd, h);
}

typedef float v2 __attribute__((ext_vector_type(2)));
typedef float v4 __attribute__((ext_vector_type(4)));
constexpr int FN = 8192;
constexpr int XPAD = 9216;
DI v2 mk2(float x, float y) { v2 r; r.x = x; r.y = y; return r; }
DI v2 cmul(v2 a, v2 t) { return __builtin_elementwise_fma(a.yy, mk2(-t.y, t.x), a.xx * t); }
DI v2 cmulc(v2 a, v2 t) { return __builtin_elementwise_fma(a.yy, mk2(t.y, t.x), a.xx * mk2(t.x, -t.y)); }
DI v2 twid2(float frac) { return mk2(COSREV(frac), -SINREV(frac)); }
DI v2 twidc2(float frac) { return mk2(COSREV(frac), SINREV(frac)); }
DI int xaddr(int i) { return (i + ((i >> 7) << 4)) ^ (((i >> 5) & 7) << 1); }

struct Tw8 { v2 t00, t01, t02, t03, t10, t11, t2; };
DI Tw8 tw8(float frac) {
  const float r = 0.70710678118654752f;
  const v2 w = twid2(frac), w2 = cmul(w, w), w4 = cmul(w2, w2);
  Tw8 t; t.t00 = w; t.t01 = mk2((w.x + w.y) * r, (w.y - w.x) * r); t.t02 = mk2(w.y, -w.x); t.t03 = mk2((w.y - w.x) * r, -(w.x + w.y) * r);
  t.t10 = w2; t.t11 = mk2(w2.y, -w2.x); t.t2 = w4; return t;
}
template <bool INV> DI void bfly(v2& a, v2& b, v2 t) {
  if (!INV) { const v2 s = a + b, d = a - b; a = s; b = cmul(d, t); }
  else { const v2 u = cmulc(b, t); const v2 s = a + u; b = a - u; a = s; }
}
template <bool INV> DI void fft8(v2 (&v)[8], const Tw8& t) {
  if (!INV) {
    bfly<false>(v[0], v[4], t.t00); bfly<false>(v[1], v[5], t.t01); bfly<false>(v[2], v[6], t.t02); bfly<false>(v[3], v[7], t.t03);
    bfly<false>(v[0], v[2], t.t10); bfly<false>(v[1], v[3], t.t11); bfly<false>(v[4], v[6], t.t10); bfly<false>(v[5], v[7], t.t11);
    bfly<false>(v[0], v[1], t.t2); bfly<false>(v[2], v[3], t.t2); bfly<false>(v[4], v[5], t.t2); bfly<false>(v[6], v[7], t.t2);
  } else {
    bfly<true>(v[0], v[1], t.t2); bfly<true>(v[2], v[3], t.t2); bfly<true>(v[4], v[5], t.t2); bfly<true>(v[6], v[7], t.t2);
    bfly<true>(v[0], v[2], t.t10); bfly<true>(v[1], v[3], t.t11); bfly<true>(v[4], v[6], t.t10); bfly<true>(v[5], v[7], t.t11);
    bfly<true>(v[0], v[4], t.t00); bfly<true>(v[1], v[5], t.t01); bfly<true>(v[2], v[6], t.t02); bfly<true>(v[3], v[7], t.t03);
  }
}
DI v2 mulw16(v2 a, int e, bool conj) {
  const float c1 = 0.92387953251128674f, s1 = 0.38268343236508977f, r = 0.70710678118654752f;
  if (e == 0) return a;
  if (e == 4) return conj ? mk2(-a.y, a.x) : mk2(a.y, -a.x);
  float cx, sy;
  if (e == 1) { cx = c1; sy = s1; } else if (e == 2) { cx = r; sy = r; } else if (e == 3) { cx = s1; sy = c1; }
  else if (e == 5) { cx = -s1; sy = c1; } else if (e == 6) { cx = -r; sy = r; } else { cx = -c1; sy = s1; }
  const float cy = conj ? sy : -sy;
  return __builtin_elementwise_fma(a.yy, mk2(-cy, cx), a.xx * mk2(cx, cy));
}
DI void fft16_fwd(v2 (&v)[16]) {
#pragma unroll
  for (int r = 0; r < 4; ++r) {
    const int hk = 16 >> (r + 1);
#pragma unroll
    for (int k = 0; k < 16; ++k) if ((k & hk) == 0) {
      const int e = (k & (hk - 1)) << r;
      const v2 a = v[k], b = v[k + hk];
      v[k] = a + b; v[k + hk] = mulw16(a - b, e, false);
    }
  }
}
DI void fft16_inv(v2 (&v)[16]) {
#pragma unroll
  for (int r = 3; r >= 0; --r) {
    const int hk = 16 >> (r + 1);
#pragma unroll
    for (int k = 0; k < 16; ++k) if ((k & hk) == 0) {
      const int e = (k & (hk - 1)) << r;
      const v2 a = v[k], u = mulw16(v[k + hk], e, true);
      v[k] = a + u; v[k + hk] = a - u;
    }
  }
}

template <int P, bool INV, int HOOK, class LDG, class XF>
DI void fpass(v2* X, int tid, LDG ldg, XF xf) {
  v2 pre[4][8];
  if constexpr (HOOK != 0) {
    int tq = tid; asm volatile("" : "+v"(tq));
#pragma unroll
    for (int gi = 0; gi < 4; ++gi)
#pragma unroll
      for (int k = 0; k < 8; ++k) pre[gi][k] = ldg(tq + 256 * gi + 1024 * k);
  }
  auto body = [&](const int gi) __attribute__((always_inline)) {
    int g = tid + 256 * gi; asm volatile("" : "+v"(g));
    int a0, a1 = 0, a2 = 0, a3 = 0; float frac;
    if (P == 0) { a0 = (g + ((g >> 7) << 4)) ^ (((g >> 5) & 7) << 1); frac = (float)g * (1.0f / 8192.0f); }
    else if (P == 1) { const int gl = g & 127; a0 = (1152 * (g >> 7) + gl) ^ (((gl >> 5) & 3) << 1); a1 = a0 ^ 8; frac = (float)gl * (1.0f / 1024.0f); }
    else { const int pp = (g & 15) ^ (((g >> 4) & 1) << 3), b = 144 * (g >> 4); a0 = b + pp; a1 = b + (pp ^ 2); a2 = b + (pp ^ 4); a3 = b + (pp ^ 6);
           frac = (float)(g & 15) * (1.0f / 128.0f); }
    auto addr = [&](int k) __attribute__((always_inline)) { return P == 0 ? a0 + 1152 * k : P == 1 ? ((k & 1) ? a1 : a0) + 144 * k : ((k >> 1) == 0 ? a0 : (k >> 1) == 1 ? a1 : (k >> 1) == 2 ? a2 : a3) + 16 * k; };
    v2 v[8];
    if constexpr (HOOK != 0 && !INV) {
#pragma unroll
      for (int k = 0; k < 8; ++k) v[k] = xf(g + 1024 * k, pre[gi][k]);
    } else {
#pragma unroll
      for (int k = 0; k < 8; ++k) v[k] = X[addr(k)];
    }
    const Tw8 t = tw8(frac);
    fft8<INV>(v, t);
    if constexpr (HOOK != 0 && INV) {
#pragma unroll
      for (int k = 0; k < 8; ++k) xf(g + 1024 * k, v[k], pre[gi][k]);
    } else {
#pragma unroll
      for (int k = 0; k < 8; ++k) X[addr(k)] = v[k];
    }
  };
  if constexpr (HOOK != 0) { body(0); body(1); body(2); body(3); }
  else {
#pragma unroll 2
    for (int gi = 0; gi < 4; ++gi) body(gi);
  }
}
template <int P, bool INV> DI void fpass_lds(v2* X, int tid) { fpass<P, INV, 0>(X, tid, [](int) { return mk2(0.f, 0.f); }, [](int, v2) { return mk2(0.f, 0.f); }); }

template <int MODE>
DI void fmid16(v2* X, int tid, const v4* Gt, v4* Dst, float scl) {
#pragma unroll
  for (int gi = 0; gi < 2; ++gi) {
    int g = tid + 256 * gi; asm volatile("" : "+v"(g));
    v4 gq[8];
    if (MODE == 0) {
#pragma unroll
      for (int c = 0; c < 8; ++c) gq[c] = Gt[c * 512 + g];
    }
    const int rb = ((16 * g + 16 * (g >> 3)) << 3) + (((g >> 1) & 7) << 4);
    v2 v[16];
#pragma unroll
    for (int c = 0; c < 8; ++c) { const v4 q = *(const v4*)((const char*)X + (rb ^ (c << 4))); v[2 * c] = q.xy; v[2 * c + 1] = q.zw; }
    fft16_fwd(v);
    if (MODE == 0) {
#pragma unroll
      for (int c = 0; c < 8; ++c) { v[2 * c] = cmul(v[2 * c], gq[c].xy); v[2 * c + 1] = cmul(v[2 * c + 1], gq[c].zw); }
      fft16_inv(v);
#pragma unroll
      for (int c = 0; c < 8; ++c) { v4 q; q.xy = v[2 * c]; q.zw = v[2 * c + 1]; *(v4*)((char*)X + (rb ^ (c << 4))) = q; }
    } else {
#pragma unroll
      for (int c = 0; c < 8; ++c) { v4 q; q.xy = v[2 * c] * scl; q.zw = v[2 * c + 1] * scl; Dst[c * 512 + g] = q; }
    }
  }
}

DI float conv3(const bf16_t* row, int n, float w0, float w1, float w2, float bb) {
  const int nm = n > 0 ? n - 1 : 0, np = n < S - 1 ? n + 1 : S - 1;
  float a = bf2f(row[nm]); const float b = bf2f(row[n]); float c = bf2f(row[np]);
  a = n > 0 ? a : 0.f; c = n < S - 1 ? c : 0.f;
  return w0 * a + w1 * b + w2 * c + bb;
}

DI void hyena_spectra(const PV& p, int l, int c, char* smem, int tid) {
  v2* X = (v2*)smem;
  float* red = (float*)(smem + XPAD * 8);
  const int lane = tid & 63, wid = tid >> 6, r = lane & 31, h = lane >> 5;
  const bf16_t* hh = (const bf16_t*)(p.ws + OFF_H3) + (size_t)l * 2 * 8192 * 64;
  const bf16_t* hl = hh + (size_t)8192 * 64;
  const float* w4 = (const float*)p.in[I_HW4] + (size_t)l * 64 * 1024;
  v4* SPEC = (v4*)((float2*)(p.ws + OFF_H) + (size_t)c * 4 * FN);
  float* T0 = (float*)((float2*)(p.ws + OFF_CA) + (size_t)blockIdx.x * FN);
  float* T1 = (float*)((float2*)(p.ws + OFF_OB) + (size_t)blockIdx.x * FN);
  const float decay = fabsf(-3.0701134573253945f + (float)c * ((-15.350567286626973f + 3.0701134573253945f) / 255.0f));
  {
    bf16x8 wh[4], wq[4];
    const int wcol = (r & 1) * 512 + ((r >> 1) & 1) * 256 + c;
#pragma unroll
    for (int ks = 0; ks < 4; ++ks) {
      unsigned ph[4], pl[4];
#pragma unroll
      for (int j = 0; j < 4; ++j) {
        float v0 = 0.f, v1 = 0.f;
        if (r < 4) { v0 = w4[(size_t)(ks * 16 + 8 * h + 2 * j) * 1024 + wcol]; v1 = w4[(size_t)(ks * 16 + 8 * h + 2 * j + 1) * 1024 + wcol]; }
        ph[j] = pack2(v0, v1);
        pl[j] = pack2(v0 - lo_bf(ph[j]), v1 - hi_bf(ph[j]));
      }
      u32x4 a; a.x = ph[0]; a.y = ph[1]; a.z = ph[2]; a.w = ph[3]; wh[ks] = __builtin_bit_cast(bf16x8, a);
      u32x4 b; b.x = pl[0]; b.y = pl[1]; b.z = pl[2]; b.w = pl[3]; wq[ks] = __builtin_bit_cast(bf16x8, b);
    }
#pragma unroll 2
    for (int i = 0; i < 64; ++i) {
      const int pos = (wid + 4 * i) * 32 + r;
      const bf16_t* rh = hh + (size_t)pos * 64 + 8 * h; const bf16_t* rl = hl + (size_t)pos * 64 + 8 * h;
      bf16x8 bh[4], bl[4];
#pragma unroll
      for (int ks = 0; ks < 4; ++ks) { bh[ks] = *(const bf16x8*)(rh + ks * 16); bl[ks] = *(const bf16x8*)(rl + ks * 16); }
      f32x16 acc;
#pragma unroll
      for (int q = 0; q < 16; ++q) acc[q] = 0.f;
#pragma unroll
      for (int ks = 0; ks < 4; ++ks) { acc = MFMA32(wh[ks], bh[ks], acc); acc = MFMA32(wh[ks], bl[ks], acc); acc = MFMA32(wq[ks], bh[ks], acc); }
      if (h == 0) { const float win = expf(-((float)pos / 8191.0f) * decay);
        T0[pos] = acc[0] * win; T0[8192 + pos] = acc[1] * win; T1[pos] = acc[2] * win; T1[8192 + pos] = acc[3] * win; }
    }
  }
  sync_mem();
#pragma unroll 1
  for (int o = 0; o < 2; ++o) {
    const float* Tf = o == 0 ? T0 : T1; const float* Tb = Tf + 8192;
    int t2 = tid; asm volatile("" : "+v"(t2));
    float ss = 0.f;
#pragma unroll 8
    for (int i = 0; i < 32; ++i) { const int n = t2 + 256 * i;
      const float f = Tf[n], bn = Tb[n], bm = Tb[(8192 - n) & 8191];
      float e; if (n == 0) { e = f + bn; ss += e * e; } else { e = f + bm; ss += f * f + bn * bn; }
      X[xaddr(n)] = mk2(e, 0.f); }
    ss = wave_sum(ss, lane);
    if (lane == 0) red[wid] = ss;
    __syncthreads();
    const float scl = rsqrtf(red[0] + red[1] + red[2] + red[3] + EPS) * (0.5f / 8192.0f);
    fpass_lds<0, false>(X, tid); __syncthreads(); fpass_lds<1, false>(X, tid); __syncthreads(); fpass_lds<2, false>(X, tid); __syncthreads();
    fmid16<1>(X, tid, nullptr, SPEC + (size_t)(o * 2 + 0) * (FN / 2), scl);
    __syncthreads();
    asm volatile("" : "+v"(t2));
#pragma unroll 8
    for (int i = 0; i < 32; ++i) { const int n = t2 + 256 * i;
      const float f = Tf[n], bm = Tb[(8192 - n) & 8191];
      const float d = n == 0 ? f + bm : f - bm;
      const v2 w = twid2((float)n * (1.0f / 16384.0f));
      X[xaddr(n)] = d * w; }
    __syncthreads();
    fpass_lds<0, false>(X, tid); __syncthreads(); fpass_lds<1, false>(X, tid); __syncthreads(); fpass_lds<2, false>(X, tid); __syncthreads();
    fmid16<1>(X, tid, nullptr, SPEC + (size_t)(o * 2 + 1) * (FN / 2), scl);
    __syncthreads();
  }
  sync_mem();
}

DI void hyena_conv(const PV& p, int l, int c, char* smem, int tid) {
  v2* X = (v2*)smem;
  const v4* SPEC = (const v4*)((float2*)(p.ws + OFF_H) + (size_t)c * 4 * FN);
  v2* zb = (v2*)((float2*)(p.ws + OFF_CA) + (size_t)blockIdx.x * FN);
  v2* ob = (v2*)((float2*)(p.ws + OFF_OB) + (size_t)blockIdx.x * FN);
  const bf16_t* HY = (const bf16_t*)(p.ws + OFF_HY);
  const float* cw = (const float*)p.in[I_CONVW] + (size_t)l * 3 * 768;
  const float* cb = (const float*)p.in[I_CONVB] + (size_t)l * 768;
  bf16_t* HYO = (bf16_t*)(p.ws + OFF_HYO);
#pragma unroll 1
  for (int pr = 0; pr < 2; ++pr) {
    const int b0 = 2 * pr, b1 = 2 * pr + 1;
    { const bf16_t* r0 = HY + ((size_t)b0 * 768 + c) * S; const bf16_t* r1 = HY + ((size_t)b1 * 768 + c) * S;
      const float w0 = cw[c], w1 = cw[768 + c], w2 = cw[1536 + c], bb = cb[c];
      int tq = tid; asm volatile("" : "+v"(tq));
#pragma unroll 16
      for (int i = 0; i < 32; ++i) { const int n = tq + 256 * i; zb[n] = mk2(conv3(r0, n, w0, w1, w2, bb), conv3(r1, n, w0, w1, w2, bb)); } }
#pragma unroll 1
    for (int o = 0; o < 2; ++o) {
      const v4* Ge = SPEC + (size_t)(o * 2 + 0) * (FN / 2); const v4* Go = SPEC + (size_t)(o * 2 + 1) * (FN / 2);
      const float bias = ((const float*)p.in[I_HBIAS])[(size_t)l * 512 + o * 256 + c];
      fpass<0, false, 1>(X, tid, [&](int n) { return zb[n]; }, [&](int n, v2 raw) { return cmul(raw, twid2((float)n * (1.0f / 16384.0f))); });
      __syncthreads(); fpass_lds<1, false>(X, tid); __syncthreads(); fpass_lds<2, false>(X, tid); __syncthreads();
      fmid16<0>(X, tid, Go, nullptr, 0.f);
      __syncthreads(); fpass_lds<2, true>(X, tid); __syncthreads(); fpass_lds<1, true>(X, tid); __syncthreads();
      fpass<0, true, 1>(X, tid, [&](int n) { return zb[n]; },
                        [&](int n, v2 v, v2 raw) { ob[n] = cmul(v, twidc2((float)n * (1.0f / 16384.0f))) + bias * raw; });
      const int gc = (o + 1) * 256 + c;
      const bf16_t* g0 = HY + ((size_t)b0 * 768 + gc) * S; const bf16_t* g1 = HY + ((size_t)b1 * 768 + gc) * S;
      const float w0 = cw[gc], w1 = cw[768 + gc], w2 = cw[1536 + gc], bb = cb[gc];
      fpass<0, false, 1>(X, tid, [&](int n) { return zb[n]; }, [&](int, v2 raw) { return raw; });
      __syncthreads(); fpass_lds<1, false>(X, tid); __syncthreads(); fpass_lds<2, false>(X, tid); __syncthreads();
      fmid16<0>(X, tid, Ge, nullptr, 0.f);
      __syncthreads(); fpass_lds<2, true>(X, tid); __syncthreads(); fpass_lds<1, true>(X, tid); __syncthreads();
      fpass<0, true, 1>(X, tid, [&](int n) { return ob[n]; },
                        [&](int n, v2 v, v2 raw) { zb[n] = mk2(conv3(g0, n, w0, w1, w2, bb) * (v.x + raw.x), conv3(g1, n, w0, w1, w2, bb) * (v.y + raw.y)); });
    }
    int tq = tid; asm volatile("" : "+v"(tq));
#pragma unroll 8
    for (int i = 0; i < 32; ++i) { const int n = tq + 256 * i; const v2 zz = zb[n];
      HYO[((size_t)b0 * 256 + c) * S + n] = f2bf(zz.x); HYO[((size_t)b1 * 256 + c) * S + n] = f2bf(zz.y); }
  }
  __syncthreads();
}

DI void hyena_item(const PV& p, int l, int c, char* smem, int tid) {
  hyena_spectra(p, l, c, smem, tid);
  asm volatile("" : "+v"(tid), "+s"(c), "+s"(l));
  hyena_conv(p, l, c, smem, tid);
}

constexpr int Q_HY = 32, Q_DIFF = 128, Q_MLA = 128, Q_SWA = 128, Q_LEN = Q_HY + Q_DIFF + Q_MLA + Q_SWA;

DI void phase_l2(const PV& p, int l, char* smem, int wv, int qoff = 0) {
  unsigned* qh = (unsigned*)(p.ws + OFF_CTRL) + CT_QHEAD + l * 8 * 64 + qoff;
  const bool hyena_first = blockIdx.x >= (gridDim.x >> 1);
#pragma unroll 1
  for (int pass = 0; pass < 2; ++pass) {
    if ((pass == 0) == hyena_first) {
      xcd_queue_run(qh + 5, smem, wv, [](int) { return Q_HY; }, [&](int x, int idx, int t) { hyena_item(p, l, x * 32 + idx, smem, t); });
    } else {
      xcd_queue_run(qh, smem, wv, [](int) { return Q_DIFF + Q_MLA + Q_SWA; }, [&](int x, int idx, int t) {
        if (idx < Q_MLA) mla_item(p, x * 2 + (idx >> 6), idx & 63, smem, t);
        else if (idx < Q_DIFF + Q_MLA) { const int j = idx - Q_MLA; diff_item(p, l, x * 2 + (j >> 6), j & 63, smem, t); }
        else { const int j = idx - Q_DIFF - Q_MLA; swa_item(p, l, x * 2 + (j >> 6), j & 63, smem, t); }
      });
    }
  }
}

DI void phase_l3a(const PV& p, int l, char* smem, int wv) {
  const bf16_t* MIX = (const bf16_t*)(p.ws + OFF_MIX);
  const bf16_t* W = (const bf16_t*)(p.ws + OFF_WOUT) + (size_t)l * 1024 * 1024;
  const float* mod = (const float*)(p.ws + OFF_MOD);
  bf16_t* XB = (bf16_t*)p.out;
  xcd_queue_run((unsigned*)(p.ws + OFF_CTRL) + CT_QHEAD + l * 8 * 64 + 2, smem, wv, [](int) { return 256; }, [&](int x, int idx, int tid) {
    const int mg = idx >> 6, rem = idx & 63; const int nt = rem >> 3, mt = x * 32 + mg * 8 + (rem & 7); const int m0 = mt * 128; const int b = m0 >> 13;
    const float* g1 = mod + (size_t)(l * NB + b) * 6144 + 2 * 1024;
    const bf16_t* A = MIX + (size_t)m0 * 1024;
    gemm_tile_l3a(A, (const bf16_t*)(p.ws + OFF_HYO) + (size_t)b * 256 * S + (m0 & 8191), W + (size_t)nt * 128 * 1024, smem, tid,
      [&](f32x16 (&acc)[2][2], int wm, int wn, int r, int h) {
        const bool odd = r & 1;
        unsigned xo[2][2][8];
#pragma unroll
        for (int ni = 0; ni < 2; ++ni)
#pragma unroll
          for (int mi = 0; mi < 2; ++mi) { const int col = nt * 128 + wn * 64 + ni * 32 + r;
            const bf16_t* xc = XB + (size_t)(m0 + wm * 64 + mi * 32 + 4 * h + (odd ? 1 : 0)) * 2048 + (col & ~1);
#pragma unroll
            for (int pq = 0; pq < 8; ++pq) xo[ni][mi][pq] = *(const unsigned*)(xc + (size_t)((2 * pq & 3) + 8 * (pq >> 1)) * 2048); }
#pragma unroll
        for (int ni = 0; ni < 2; ++ni) { const int col = nt * 128 + wn * 64 + ni * 32 + r; const float gv = g1[col];
#pragma unroll
          for (int mi = 0; mi < 2; ++mi) { bf16_t* xc = XB + (size_t)(m0 + wm * 64 + mi * 32 + 4 * h + (odd ? 1 : 0)) * 2048 + (col & ~1);
            float mine[8], theirs[8];
#pragma unroll
            for (int pq = 0; pq < 8; ++pq) { const float a0 = gv * acc[mi][ni][2 * pq], a1 = gv * acc[mi][ni][2 * pq + 1];
              const float send = odd ? a0 : a1; mine[pq] = odd ? a1 : a0;
              theirs[pq] = __builtin_bit_cast(float, __builtin_amdgcn_mov_dpp(__builtin_bit_cast(int, send), 0xB1, 0xF, 0xF, true)); }
#pragma unroll
            for (int pq = 0; pq < 8; ++pq) { const float lo = lo_bf(xo[ni][mi][pq]) + (odd ? theirs[pq] : mine[pq]), hi = hi_bf(xo[ni][mi][pq]) + (odd ? mine[pq] : theirs[pq]);
              *(unsigned*)(xc + (size_t)((2 * pq & 3) + 8 * (pq >> 1)) * 2048) = pack2(lo, hi); }
          }
        }
      });
  });
}

DI void phase_l3b(const PV& p, int l, char* smem, int tid) {
  const bf16_t* WR = (const bf16_t*)(p.ws + OFF_WR) + (size_t)l * 128 * 1024;
  const float* mod = (const float*)(p.ws + OFF_MOD);
  const bf16_t* XB = (const bf16_t*)p.out;
  bf16_t* H = (bf16_t*)(p.ws + OFF_H);
  unsigned* cnt = (unsigned*)(p.ws + OFF_CTRL) + CT_CNT + l * 32;
  int* toke = (int*)(p.ws + OFF_TOKE); int* tokp = (int*)(p.ws + OFF_TOKP);
  int* ltok = (int*)(p.ws + OFF_LTOK); float* lgate = (float*)(p.ws + OFF_LGATE);
  float* logit = (float*)(smem + 55296);
  int* hist = (int*)(smem + 55296 + 64 * 40 * 4);
  int* gbase = hist + 32;
  const float* lnw = (const float*)p.in[I_LN2] + l * 1024;
  for (int mt = blockIdx.x; mt < 512; mt += gridDim.x) {
    const int m0 = mt * 64; const int b = m0 >> 13;
    asm volatile("" : "+v"(tid));
    const int lane = tid & 63, wid = tid >> 6;
    const float* sh2 = mod + (size_t)(l * NB + b) * 6144 + 3 * 1024; const float* sc2 = sh2 + 1024;
#pragma unroll 1
    for (int rr = 0; rr < 16; rr += 4) {
      f32x4 xv[4][4]; float ss[4];
#pragma unroll
      for (int q = 0; q < 4; ++q) { const bf16_t* src = XB + (size_t)(m0 + wid * 16 + rr + q) * 2048 + lane * 4;
#pragma unroll
        for (int i = 0; i < 4; ++i) { const u32x2 xb = *(const u32x2*)(src + 256 * i); xv[q][i].x = lo_bf(xb.x); xv[q][i].y = hi_bf(xb.x); xv[q][i].z = lo_bf(xb.y); xv[q][i].w = hi_bf(xb.y); } }
#pragma unroll
      for (int q = 0; q < 4; ++q) { float a = 0.f;
#pragma unroll
        for (int i = 0; i < 4; ++i) a += xv[q][i].x * xv[q][i].x + xv[q][i].y * xv[q][i].y + xv[q][i].z * xv[q][i].z + xv[q][i].w * xv[q][i].w;
        ss[q] = wave_sum(a, lane); }
#pragma unroll
      for (int q = 0; q < 4; ++q) { const float rstd = rsqrtf(ss[q] * (1.0f / 1024.0f) + EPS); const int row = m0 + wid * 16 + rr + q;
#pragma unroll
        for (int i = 0; i < 4; ++i) { const int c = lane * 4 + 256 * i;
          const f32x4 g = *(const f32x4*)(lnw + c), s1 = *(const f32x4*)(sc2 + c), s0 = *(const f32x4*)(sh2 + c);
          u32x2 o; o.x = pack2(xv[q][i].x * rstd * g.x * (1.f + s1.x) + s0.x, xv[q][i].y * rstd * g.y * (1.f + s1.y) + s0.y);
          o.y = pack2(xv[q][i].z * rstd * g.z * (1.f + s1.z) + s0.z, xv[q][i].w * rstd * g.w * (1.f + s1.w) + s0.w);
          *(u32x2*)(H + (size_t)row * 1024 + c) = o; } }
    }
    if (tid < 32) hist[tid] = 0;
    sync_mem();
    const bf16_t* A2 = H + (size_t)m0 * 1024;
    gemm_tile<64, true>([&](int row) { return A2 + (size_t)row * 1024; }, WR, 1024, 1024, smem, tid,
      [&](f32x16 (&acc)[1][2], int wm, int wn, int r, int h) {
        if (wn == 0) {
#pragma unroll
          for (int ni = 0; ni < 2; ++ni)
#pragma unroll
            for (int i = 0; i < 16; ++i) { const int col = ni * 32 + crow(i, h); if (col < 36) logit[(wm * 32 + r) * 40 + col] = acc[0][ni][i]; }
        }
      });
    __syncthreads();
    int e0 = 0, e1 = 0, r0 = 0, r1 = 0; float gt0 = 0.f, gt1 = 0.f;
    if (tid < 64) {
      const float* lg = logit + tid * 40;
      const float* rgb = (const float*)p.in[I_RGB] + l * 4; const float* reb = (const float*)p.in[I_REB] + l * 32;
      float gl[4]; int gs = 0; float gm;
#pragma unroll
      for (int j = 0; j < 4; ++j) gl[j] = lg[j] + rgb[j];
      gm = gl[0];
#pragma unroll
      for (int j = 1; j < 4; ++j) if (gl[j] > gm) { gm = gl[j]; gs = j; }
      float den = 0.f;
#pragma unroll
      for (int j = 0; j < 4; ++j) den += expf(gl[j] - gm);
      const float pg = 1.0f / den;
      float v0 = -INFINITY, v1 = -INFINITY; int i0 = 0, i1 = 0;
      for (int j = 0; j < 8; ++j) { const float v = lg[4 + gs * 8 + j] + reb[gs * 8 + j];
        if (v > v0) { v1 = v0; i1 = i0; v0 = v; i0 = j; } else if (v > v1) { v1 = v; i1 = j; } }
      const float w0 = 1.0f / (1.0f + expf(v1 - v0));
      e0 = gs * 8 + i0; e1 = gs * 8 + i1; gt0 = pg * w0; gt1 = pg * (1.0f - w0);
      r0 = atomicAdd(&hist[e0], 1); r1 = atomicAdd(&hist[e1], 1);
    }
    __syncthreads();
    if (tid < 32) { const int hc = hist[tid]; gbase[tid] = hc > 0 ? (int)atomicAdd(&cnt[tid], (unsigned)hc) : 0; }
    __syncthreads();
    if (tid < 64) {
      const int tok = m0 + tid; const int p0 = gbase[e0] + r0, p1 = gbase[e1] + r1;
      toke[tok * 2] = e0; toke[tok * 2 + 1] = e1; tokp[tok * 2] = p0; tokp[tok * 2 + 1] = p1;
      ltok[(size_t)e0 * LCAP + p0] = tok; ltok[(size_t)e1 * LCAP + p1] = tok; lgate[(size_t)e0 * LCAP + p0] = gt0; lgate[(size_t)e1 * LCAP + p1] = gt1;
    }
    __syncthreads();
  }
}

DI void moe_rb_table(const unsigned* cnt, int* rbs  , int tid) {
  if (tid == 0) { int acc = 0; for (int e = 0; e < 32; ++e) { rbs[e] = acc; acc += ((int)cnt[e] + 127) >> 7; } rbs[32] = acc; }
  __syncthreads();
}

DI void phase_m2(const PV& p, int l, char* smem, int wv) {
  int* rbs = (int*)(smem + LDS_BYTES - 256);
  const unsigned* cnt = (const unsigned*)(p.ws + OFF_CTRL) + CT_CNT + l * 32;
  moe_rb_table(cnt, rbs, my_tid(wv));
  const bf16_t* H = (const bf16_t*)(p.ws + OFF_H);
  const int* ltok = (const int*)(p.ws + OFF_LTOK);
  bf16_t* ACT = (bf16_t*)(p.ws + OFF_ACT);
  auto nrb = [&](int e) { return rbs[e + 1] - rbs[e]; };
  xcd_queue_run((unsigned*)(p.ws + OFF_CTRL) + CT_QHEAD + l * 8 * 64 + 3, smem, wv,
    [&](int x) { return (nrb(x) + nrb(x + 8) + nrb(x + 16) + nrb(x + 24)) * 4; }, [&](int x, int idx, int tid) {
    int e = x, q = idx >> 2; const int nt = idx & 3;
    while (q >= nrb(e)) { q -= nrb(e); e += 8; }
    const int rb = q, rbg = rbs[e] + rb; const int ce = (int)cnt[e];
    const size_t slot0 = (size_t)rbg * 128;
    const int* lt = ltok + (size_t)e * LCAP + rb * 128; const int nvalid = ce - rb * 128;
    const bf16_t* Bt = (const bf16_t*)(p.ws + OFF_WGU) + ((size_t)(l * 32 + e) * 512 + nt * 128) * 1024;
    gemm_tile<128, true>([&](int row) { const int tok = row < nvalid ? lt[row] : 0; return H + (size_t)tok * 1024; }, Bt, 1024, 1024, smem, tid,
      [&](f32x16 (&acc)[2][2], int wm, int wn, int r, int h) {
#pragma unroll
        for (int mi = 0; mi < 2; ++mi) { bf16_t* dst = ACT + (slot0 + wm * 64 + mi * 32 + r) * 256 + nt * 64 + wn * 32;
#pragma unroll
          for (int g = 0; g < 4; ++g) { float o[4];
#pragma unroll
            for (int k = 0; k < 4; ++k) o[k] = silu(acc[mi][0][4 * g + k]) * acc[mi][1][4 * g + k];
            store4_bf(dst + 8 * g + 4 * h, o[0], o[1], o[2], o[3]); }
        }
      });
  });
}

DI void phase_m3(const PV& p, int l, char* smem, int wv) {
  int* rbs = (int*)(smem + LDS_BYTES - 256);
  const unsigned* cnt = (const unsigned*)(p.ws + OFF_CTRL) + CT_CNT + l * 32;
  moe_rb_table(cnt, rbs, my_tid(wv));
  const bf16_t* ACT = (const bf16_t*)(p.ws + OFF_ACT);
  const float* lgate = (const float*)(p.ws + OFF_LGATE);
  bf16_t* Y = (bf16_t*)(p.ws + OFF_Y);
  auto nrb = [&](int e) { return rbs[e + 1] - rbs[e]; };
  xcd_queue_run((unsigned*)(p.ws + OFF_CTRL) + CT_QHEAD + l * 8 * 64 + 4, smem, wv,
    [&](int x) { return (nrb(x) + nrb(x + 8) + nrb(x + 16) + nrb(x + 24)) * 8; }, [&](int x, int idx, int tid) {
    int e = x, q = idx >> 3; const int nt = idx & 7;
    while (q >= nrb(e)) { q -= nrb(e); e += 8; }
    const int rb = q, rbg = rbs[e] + rb; const int ce = (int)cnt[e];
    const size_t slot0 = (size_t)rbg * 128;
    const float* lg = lgate + (size_t)e * LCAP + rb * 128; const int nvalid = ce - rb * 128;
    const bf16_t* A = ACT + slot0 * 256;
    const bf16_t* Bt = (const bf16_t*)(p.ws + OFF_WD) + ((size_t)(l * 32 + e) * 1024 + nt * 128) * 256;
    float gtv[2];
    { const int rw = ((tid >> 7) & 1) * 64 + (tid & 31);
#pragma unroll
      for (int mi = 0; mi < 2; ++mi) gtv[mi] = (rw + mi * 32) < nvalid ? lg[rw + mi * 32] : 0.f; }
    gemm_tile<128, true>([&](int row) { return A + (size_t)row * 256; }, Bt, 256, 256, smem, tid,
      [&](f32x16 (&acc)[2][2], int wm, int wn, int r, int h) {
        bf16_t* Tl = (bf16_t*)smem;
#pragma unroll
        for (int mi = 0; mi < 2; ++mi) { const int row = wm * 64 + mi * 32 + r; const float gt = gtv[mi];
#pragma unroll
          for (int ni = 0; ni < 2; ++ni)
#pragma unroll
            for (int g = 0; g < 4; ++g) store4_bf(Tl + row * 136 + wn * 64 + ni * 32 + 8 * g + 4 * h, acc[mi][ni][4 * g] * gt, acc[mi][ni][4 * g + 1] * gt, acc[mi][ni][4 * g + 2] * gt, acc[mi][ni][4 * g + 3] * gt);
        }
        __syncthreads();
#pragma unroll
        for (int i = 0; i < 8; ++i) { const int c = tid + 256 * i, row = c >> 4, ch = c & 15;
          *(u32x4*)(Y + (slot0 + row) * 1024 + nt * 128 + ch * 8) = *(const u32x4*)(Tl + row * 136 + ch * 8); }
        __syncthreads();
      });
  });
}

#define XB_TMO      128
#define XB_XCNT(j)  (256  + 64 * (j))
#define XB_XSUB(j)  (1280 + 64 * (j))
#define XB_XGEN(j)  (2304 + 64 * (j))
#define XB_TOP      3328
#define XB_TOPGEN   3392
#define XCD_BAR_WORDS 3456
#define XB_SPIN_CAP (1u << 18)
#define LAS __attribute__((address_space(3)))

__device__ __forceinline__ unsigned xb_ld(unsigned* p)              { return __hip_atomic_load(p, __ATOMIC_RELAXED, __HIP_MEMORY_SCOPE_AGENT); }
__device__ __forceinline__ unsigned xb_add(unsigned* p, unsigned v) { return __hip_atomic_fetch_add(p, v, __ATOMIC_RELAXED, __HIP_MEMORY_SCOPE_AGENT); }
__device__ __forceinline__ unsigned xb_xcc_id() { return (unsigned)__builtin_amdgcn_s_getreg((3 << 11) | 20) & 0xFu; }
#define XB_SPIN(cond, bar) do { unsigned _sp = 0; while (cond) { __builtin_amdgcn_s_sleep(1); \
    if ((++_sp & 255u) == 0u) { if (xb_ld(&(bar)[XB_TMO])) break; if (_sp > XB_SPIN_CAP) { atomicAdd(&(bar)[XB_TMO], 1u); break; } } } } while (0)

struct XcdBarrier {
    unsigned* bar; unsigned x;
    volatile LAS unsigned* st;
};
__device__ __forceinline__ XcdBarrier xcd_barrier_post(unsigned* bar, volatile LAS unsigned* st) {
    XcdBarrier b; b.bar = bar; b.x = xb_xcc_id(); b.st = st;
    if (threadIdx.x == 0) (void)xb_add(&bar[XB_XCNT(b.x)], 1u);
    return b;
}
__device__ __forceinline__ void xcd_barrier_complete(unsigned* bar, unsigned x, unsigned& nloc, unsigned& nx) {
    const unsigned G = gridDim.x * gridDim.y * gridDim.z;
    unsigned sum, cnt, mine, sp = 0u;
    for (;;) {
        sum = 0u; cnt = 0u; mine = 0u;
#pragma unroll
        for (unsigned j = 0; j < 16; ++j) { const unsigned c = xb_ld(&bar[XB_XCNT(j)]); sum += c; cnt += (c > 0u) ? 1u : 0u; mine = (j == x) ? c : mine; }
        if (sum == G) break;
        __builtin_amdgcn_s_sleep(1);
        if ((++sp & 255u) == 0u) { if (xb_ld(&bar[XB_TMO])) break; if (sp > XB_SPIN_CAP) { atomicAdd(&bar[XB_TMO], 1u); break; } }
    }
    nloc = mine > 0u ? mine : 1u; nx = cnt > 0u ? cnt : 1u;
}
__device__ __forceinline__ void xcd_barrier(const XcdBarrier& b, const bool is_t0  ) {
    asm volatile("s_waitcnt vmcnt(0)" ::: "memory");
    __syncthreads();
    if (is_t0) {
        unsigned* bar = b.bar;
        __builtin_amdgcn_s_waitcnt(0);
        unsigned nloc = b.st[0], nx = b.st[1];
        if (nloc == 0u) { xcd_barrier_complete(bar, b.x, nloc, nx); b.st[0] = nloc; b.st[1] = nx; }
        const unsigned old = xb_add(&bar[XB_XSUB(b.x)], 1u);
        const unsigned gen = old / nloc;
        if (old + 1u == (gen + 1u) * nloc) {
            __builtin_amdgcn_fence(__ATOMIC_RELEASE, "agent");
            asm volatile("s_waitcnt vmcnt(0)" ::: "memory");
            const unsigned og = xb_add(&bar[XB_TOP], 1u);
            const unsigned tg = og / nx;
            if (og + 1u == (tg + 1u) * nx) xb_add(&bar[XB_TOPGEN], 1u);
            else XB_SPIN(xb_ld(&bar[XB_TOPGEN]) == tg, bar);
            __builtin_amdgcn_fence(__ATOMIC_ACQUIRE, "agent");
            xb_add(&bar[XB_XGEN(b.x)], 1u);
            asm volatile("s_waitcnt vmcnt(0)" ::: "memory");
        } else {
            XB_SPIN(xb_ld(&bar[XB_XGEN(b.x)]) == gen, bar);
            __builtin_amdgcn_fence(__ATOMIC_ACQUIRE, "agent");
            asm volatile("s_waitcnt vmcnt(0)" ::: "memory");
        }
    }
    __syncthreads();
}

#ifndef DUP_PHASE
#define DUP_PHASE 0
#endif
constexpr int CT_BAR = 8192;
#define MYTID my_tid(wv)
#define PHASE(call) { const PV p = mkpv(); int t = MYTID; asm volatile("" : "+v"(t)); call; }
DI void gbar(XcdBarrier b, int t) { asm volatile("" : "+s"(b.bar), "+s"(b.x)); xcd_barrier(b, t == 0); }

__global__ void __launch_bounds__(NTHREADS, 2) k_mega(Params pk) {
  extern __shared__ __attribute__((aligned(16))) char smem[];
  const int wv = __builtin_amdgcn_readfirstlane((int)(threadIdx.x >> 6));
  volatile LAS unsigned* xbw = (volatile LAS unsigned*)(smem + LDS_BYTES - 64);
  if (threadIdx.x == 0) { xbw[0] = 0u; xbw[1] = 0u; xbw[2] = 0u; xbw[3] = 0u; }
  __syncthreads();
  XcdBarrier bar = xcd_barrier_post((unsigned*)(pk.ws + OFF_CTRL) + CT_BAR, xbw);
  PHASE(phase_pa(p, smem, t))
  gbar(bar, MYTID);
#if DUP_PHASE == 1
  PHASE(phase_pa(p, smem, t))
  gbar(bar, MYTID);
#endif
#pragma unroll 1
  for (int l = 0; l < NL; ++l) {
    PHASE(phase_l0<false>(p, l, smem, t))
    gbar(bar, MYTID);
    { const PV p = mkpv(); phase_l1(p, l, smem, wv); }
    gbar(bar, MYTID);
#if DUP_PHASE == 2
    { const PV p = mkpv(); phase_l1(p, l, smem, wv); }
    gbar(bar, MYTID);
#endif
    PHASE(phase_l1b(p, l, smem, t))
    gbar(bar, MYTID);
#if DUP_PHASE == 3
    PHASE(phase_l1b(p, l, smem, t))
    gbar(bar, MYTID);
#endif
    { const PV p = mkpv(); phase_l2(p, l, smem, wv); }
    gbar(bar, MYTID);
#if DUP_PHASE == 4
    { const PV p = mkpv(); phase_l2(p, l, smem, wv, 32); }
    gbar(bar, MYTID);
#endif
    { const PV p = mkpv(); phase_l3a(p, l, smem, wv); }
    gbar(bar, MYTID);
    PHASE(phase_l3b(p, l, smem, t))
    gbar(bar, MYTID);
    { const PV p = mkpv(); phase_m2(p, l, smem, wv); }
    gbar(bar, MYTID);
#if DUP_PHASE == 5
    { const PV p = mkpv(); phase_m2(p, l, smem, wv); }
    gbar(bar, MYTID);
#endif
    { const PV p = mkpv(); phase_m3(p, l, smem, wv); }
    gbar(bar, MYTID);
#if DUP_PHASE == 6
    { const PV p = mkpv(); phase_m3(p, l, smem, wv); }
    gbar(bar, MYTID);
#endif
  }
  PHASE(phase_l0<true>(p, NL, smem, t))
}

extern "C" void kernel_launch(void* const* d_in, const int* in_sizes, int n_in, void* d_out, int out_size, void* d_ws, size_t ws_size, hipStream_t stream) {
  (void)in_sizes; (void)out_size;
  if (n_in < N_IN || ws_size < WS_NEEDED) { fprintf(stderr, "kernel_launch: unexpected inputs / workspace (%d, %zu < %zu)\n", n_in, ws_size, (size_t)WS_NEEDED); return; }
  static int grid = 0;
  if (!grid) {
    int dev = 0, cus = 0, per_cu = 0;
    (void)hipGetDevice(&dev);
    (void)hipDeviceGetAttribute(&cus, hipDeviceAttributeMultiprocessorCount, dev);
    (void)hipFuncSetAttribute((const void*)k_mega, hipFuncAttributeMaxDynamicSharedMemorySize, LDS_BYTES);
    (void)hipOccupancyMaxActiveBlocksPerMultiprocessor(&per_cu, k_mega, NTHREADS, LDS_BYTES);
    if (cus <= 0) cus = 256;
    if (per_cu < 1) per_cu = 1;
    grid = cus * (per_cu < 2 ? per_cu : 2);
    if (grid > GRID) grid = GRID;
  }
  Params p{};
  for (int i = 0; i < N_IN; ++i) p.in[i] = d_in[i];
  p.out = (float*)d_out; p.ws = (char*)d_ws;
  (void)hipMemsetAsync((char*)d_ws + OFF_CTRL, 0, 65536, stream);
  hipLaunchKernelGGL(k_mega, dim3(grid), dim3(NTHREADS), LDS_BYTES, stream, p);
}
```
